# Optimizing an MI355X kernel written in HIP

```python
import jax, jax.numpy as jnp
from jax import lax
import numpy as np

D_MODEL = 2048
BATCH = 4
SEQ = 2048
DEPTH = 1

PLE_DIM = 256
CONV_DIM = 1024
CONV_K = 3
MLSTM_HEADS = 4
MLSTM_HEAD_DIM = 256
MLSTM_DIM = MLSTM_HEADS * MLSTM_HEAD_DIM
MLSTM_CHUNK = 128
MIX_DIM = CONV_DIM + MLSTM_DIM
IN_COLS = 3 * CONV_DIM + 4 * MLSTM_DIM + 2 * MLSTM_HEADS
PEER_HEADS = 8
PEER_N_KEYS = 128
PEER_N_EXPERTS = PEER_N_KEYS * PEER_N_KEYS
PEER_KEY_DIM = 256
PEER_HALF = PEER_KEY_DIM // 2
PEER_TOPK = 16
PEER_TOKEN_BLOCK = 128
EPS = 1e-6

kernel_name = "hybrid_conv_mlstm_peer_block"


def rmsnorm(x, g):
    xf = x.astype(jnp.float32)
    r = lax.rsqrt(jnp.mean(xf * xf, axis=-1, keepdims=True) + EPS)
    return (xf * r).astype(x.dtype) * g


def short_conv(b_gate, c_gate, u, w):
    z = c_gate * u
    s = z.shape[1]
    zp = jnp.pad(z, ((0, 0), (CONV_K - 1, 0), (0, 0)))
    y = w[0] * zp[:, 0:s]
    for j in range(1, CONV_K):
        y = y + w[j] * zp[:, j:j + s]
    return b_gate * y


def mlstm_chunkwise(q, k, v, i_pre, f_pre):
    bsz, s, nh, d = q.shape
    L = MLSTM_CHUNK
    nc = s // L

    def to_chunks(t):
        t = t.reshape((bsz, nc, L, nh) + t.shape[3:])
        return jnp.moveaxis(t, (1, 3), (0, 2))

    f32 = jnp.float32
    qc = to_chunks(q.astype(f32))
    kc = to_chunks(k.astype(f32)) * (d ** -0.5)
    vc = to_chunks(v.astype(f32))
    ic = to_chunks(i_pre.astype(f32))
    lfc = to_chunks(jax.nn.log_sigmoid(f_pre.astype(f32)))
    causal = jnp.tril(jnp.ones((L, L), dtype=bool))

    def step(carry, inp):
        C, n, m = carry
        qt, kt, vt, it, lft = inp
        b = jnp.cumsum(lft, axis=-1)
        dmat = jnp.where(causal, b[..., :, None] - b[..., None, :] + it[..., None, :], -jnp.inf)
        inter = b + m[..., None]
        m_t = jnp.maximum(inter, jnp.max(dmat, axis=-1))
        pw = jnp.exp(dmat - m_t[..., None])
        sc = jnp.einsum('bhtd,bhsd->bhts', qt, kt) * pw
        a = jnp.exp(inter - m_t)
        num = a[..., None] * jnp.einsum('bhtd,bhde->bhte', qt, C) + jnp.einsum('bhts,bhse->bhte', sc, vt)
        den = a * jnp.einsum('bhtd,bhd->bht', qt, n) + jnp.sum(sc, axis=-1)
        h = num / jnp.maximum(jnp.abs(den), jnp.exp(-m_t))[..., None]
        m_new = m_t[..., -1]
        w_s = jnp.exp(b[..., -1:] - b + it - m_new[..., None])
        a_l = jnp.exp(b[..., -1] + m - m_new)
        C_new = a_l[..., None, None] * C + jnp.einsum('bhs,bhsd,bhse->bhde', w_s, kt, vt)
        n_new = a_l[..., None] * n + jnp.einsum('bhs,bhsd->bhd', w_s, kt)
        return (C_new, n_new, m_new), h

    init = (jnp.zeros((bsz, nh, d, d), f32), jnp.zeros((bsz, nh, d), f32), jnp.zeros((bsz, nh), f32))
    _, hs = lax.scan(step, init, (qc, kc, vc, ic, lfc))
    return jnp.moveaxis(hs, (0, 2), (1, 3)).reshape(bsz, s, nh, d)


def peer(xn, wq, sub_keys, u_tab, v_tab):
    bsz, s, dm = xn.shape
    q = (xn @ wq).reshape(bsz, s, PEER_HEADS, 2, PEER_HALF)
    scores = jnp.einsum('bshpc,hpnc->bshpn', q, sub_keys).astype(jnp.float32)
    s_top, i_top = lax.top_k(scores, PEER_TOPK)
    cand_s = s_top[..., 0, :, None] + s_top[..., 1, None, :]
    cand_i = i_top[..., 0, :, None] * PEER_N_KEYS + i_top[..., 1, None, :]
    cand_s = cand_s.reshape(bsz, s, PEER_HEADS, PEER_TOPK * PEER_TOPK)
    cand_i = cand_i.reshape(bsz, s, PEER_HEADS, PEER_TOPK * PEER_TOPK)
    best_s, pos = lax.top_k(cand_s, PEER_TOPK)
    idx = jnp.take_along_axis(cand_i, pos, axis=-1)
    gate = jax.nn.softmax(best_s, axis=-1).astype(xn.dtype)
    nb = (bsz * s) // PEER_TOKEN_BLOCK
    xb = xn.reshape(nb, PEER_TOKEN_BLOCK, dm)
    ib = idx.reshape(nb, PEER_TOKEN_BLOCK, PEER_HEADS, PEER_TOPK)
    gb = gate.reshape(nb, PEER_TOKEN_BLOCK, PEER_HEADS, PEER_TOPK)

    def block(args):
        xt, it, gt = args
        u = u_tab[it]
        a = jnp.einsum('thkd,td->thk', u, xt)
        w = jax.nn.gelu(a, approximate=False) * gt
        return jnp.einsum('thk,thkd->td', w, v_tab[it])

    out = lax.map(block, (xb, ib, gb))
    return out.reshape(bsz, s, dm)


def setup_inputs(seed: int = 0) -> dict:
    key = jax.random.key(seed)
    ks = jax.random.split(key, 17)
    nrm = jax.random.normal
    f32 = jnp.float32
    x = nrm(ks[0], (BATCH, SEQ, D_MODEL), f32)
    p = nrm(ks[1], (DEPTH, BATCH, SEQ, PLE_DIM), f32)
    norm_mix_g = 1.0 + 0.02 * nrm(ks[2], (DEPTH, D_MODEL), f32)
    w_in = nrm(ks[3], (DEPTH, D_MODEL, IN_COLS), f32) * D_MODEL ** -0.5
    conv_w = nrm(ks[4], (DEPTH, CONV_K, CONV_DIM), f32) * CONV_K ** -0.5
    gate_base = jnp.concatenate([jnp.full((DEPTH, MLSTM_HEADS), -2.0, f32),
                                 jnp.broadcast_to(jnp.linspace(3.0, 6.0, MLSTM_HEADS, dtype=f32), (DEPTH, MLSTM_HEADS))], axis=-1)
    mlstm_gate_b = gate_base + 0.1 * nrm(ks[5], (DEPTH, 2 * MLSTM_HEADS), f32)
    mlstm_norm_g = 1.0 + 0.02 * nrm(ks[6], (DEPTH, MLSTM_DIM), f32)
    w_out = nrm(ks[7], (DEPTH, MIX_DIM, D_MODEL), f32) * MIX_DIM ** -0.5
    norm_ffn_g = 1.0 + 0.02 * nrm(ks[8], (DEPTH, D_MODEL), f32)
    peer_wq = nrm(ks[9], (DEPTH, D_MODEL, PEER_HEADS * PEER_KEY_DIM), f32) * D_MODEL ** -0.5
    peer_keys = nrm(ks[10], (DEPTH, PEER_HEADS, 2, PEER_N_KEYS, PEER_HALF), f32) * PEER_HALF ** -0.5
    peer_u = nrm(ks[11], (DEPTH, PEER_N_EXPERTS, D_MODEL), f32) * D_MODEL ** -0.5
    peer_v = nrm(ks[12], (DEPTH, PEER_N_EXPERTS, D_MODEL), f32) * D_MODEL ** -0.5
    norm_ple_g = 1.0 + 0.02 * nrm(ks[13], (DEPTH, D_MODEL), f32)
    ple_w_gate = nrm(ks[14], (DEPTH, D_MODEL, D_MODEL), f32) * D_MODEL ** -0.5
    ple_w_proj = nrm(ks[15], (DEPTH, PLE_DIM, D_MODEL), f32) * PLE_DIM ** -0.5
    norm_final_g = 1.0 + 0.02 * nrm(ks[16], (D_MODEL,), f32)
    return {"x": x, "p": p, "norm_mix_g": norm_mix_g, "w_in": w_in, "conv_w": conv_w,
            "mlstm_gate_b": mlstm_gate_b, "mlstm_norm_g": mlstm_norm_g, "w_out": w_out,
            "norm_ffn_g": norm_ffn_g, "peer_wq": peer_wq, "peer_keys": peer_keys,
            "peer_u": peer_u, "peer_v": peer_v, "norm_ple_g": norm_ple_g,
            "ple_w_gate": ple_w_gate, "ple_w_proj": ple_w_proj, "norm_final_g": norm_final_g}


def reference(x, p, norm_mix_g, w_in, conv_w, mlstm_gate_b, mlstm_norm_g, w_out,
              norm_ffn_g, peer_wq, peer_keys, peer_u, peer_v, norm_ple_g,
              ple_w_gate, ple_w_proj, norm_final_g):
    bsz, s, _ = x.shape
    c, m = CONV_DIM, MLSTM_DIM
    splits = [c, 2 * c, 3 * c, 3 * c + m, 3 * c + 2 * m, 3 * c + 3 * m, 3 * c + 4 * m]
    h = x
    for i in range(DEPTH):
        xn = rmsnorm(h, norm_mix_g[i])
        proj = xn @ w_in[i]
        bc, cc, uc, q, k, v, o, gates = jnp.split(proj, splits, axis=-1)
        y_conv = short_conv(bc, cc, uc, conv_w[i])
        gates = gates.astype(jnp.float32) + mlstm_gate_b[i].astype(jnp.float32)
        i_pre, f_pre = gates[..., :MLSTM_HEADS], gates[..., MLSTM_HEADS:]
        hd = (bsz, s, MLSTM_HEADS, MLSTM_HEAD_DIM)
        hm = mlstm_chunkwise(q.reshape(hd), k.reshape(hd), v.reshape(hd), i_pre, f_pre)
        hm = rmsnorm(hm, mlstm_norm_g[i].reshape(MLSTM_HEADS, MLSTM_HEAD_DIM).astype(jnp.float32))
        y_m = jax.nn.sigmoid(o) * hm.reshape(bsz, s, MLSTM_DIM).astype(x.dtype)
        h = h + jnp.concatenate([y_conv, y_m], axis=-1) @ w_out[i]
        h = h + peer(rmsnorm(h, norm_ffn_g[i]), peer_wq[i], peer_keys[i], peer_u[i], peer_v[i])
        g = jax.nn.sigmoid(rmsnorm(h, norm_ple_g[i]) @ ple_w_gate[i])
        h = h + g * (p[i] @ ple_w_proj[i])
    return rmsnorm(h, norm_final_g)
```

```cpp
#include <hip/hip_runtime.h>
#include <cstdio>
#include <cstdint>
#include <cmath>
namespace pg8 {
#define PG8_LAS __attribute__((address_space(3)))
typedef unsigned short bf16_t;
typedef short bf16x8 __attribute__((ext_vector_type(8)));
typedef float f32x4 __attribute__((ext_vector_type(4)));
typedef unsigned u32x4 __attribute__((ext_vector_type(4)));
constexpr int BM = 256, BK = 64, HALF = 128, HTB = HALF * BK * 2  , STAGE_BYTES = 8 * HTB, NXCD = 8, WGM = 8;

__host__ __device__ __forceinline__ int lds_byte(int r, int c) { const int st = (r >> 4) * 2 + (c >> 5), rr = r & 15, cc = c & 31, ob = rr * 64 + cc * 2; return st * 1024 + (ob ^ (((ob >> 9) & 1) << 5)); }
__host__ __device__ __forceinline__ void stage_rc(int b, int& R, int& C) { const int st = b / 1024, sb = b % 1024, swz = sb ^ (((sb >> 9) & 1) << 5); R = (st >> 1) * 16 + swz / 64; C = (st & 1) * 32 + (swz % 64) / 2; }
__host__ __device__ __forceinline__ int perm32(int rho) { const int n = rho >> 4, i = rho & 15; return 8 * (i >> 2) + 4 * n + (i & 3); }

struct Unit { int pm, pn; };
struct Gemm { const bf16_t* A; const bf16_t* Bt; int M, N, K; };

struct StaticOrder {
    int nM, nN, nwg, G, c;
    __host__ __device__ void init(int M, int N, int G_, int c_) { nM = M / BM; nN = N / BM; nwg = nM * nN; G = G_; c = c_; }
    __host__ __device__ bool next(int i, Unit& u) const {
        const long L = (long)i * G + c; if (L >= nwg) return false;
        int wgid = (int)L; { const int q = nwg / NXCD, r = nwg % NXCD, xcd = wgid % NXCD, off = wgid / NXCD; wgid = (xcd < r ? xcd * (q + 1) : r * (q + 1) + (xcd - r) * q) + off; }
        const int nig = WGM * nN, gid = wgid / nig, fm = gid * WGM, gsz = (nM - fm) < WGM ? (nM - fm) : WGM;
        u.pm = fm + ((wgid % nig) % gsz); u.pn = (wgid % nig) / gsz; return true;
    }
    __device__ __forceinline__ void a_ready(const Unit&) const {}
    __device__ __forceinline__ void done(const Unit&) const {}
};

__device__ __forceinline__ unsigned cvt_pk_bf16(float lo, float hi) { unsigned r; asm volatile("v_cvt_pk_bf16_f32 %0, %1, %2" : "=v"(r) : "v"(lo), "v"(hi)); return r; }
typedef float f32x2 __attribute__((ext_vector_type(2)));
__device__ __forceinline__ f32x2 gelu_pk(f32x2 v) {
    const f32x2 av = __builtin_elementwise_abs(v), d = av * 0.2316418882f + 1.0f;
    f32x2 t; t.x = __builtin_amdgcn_rcpf(d.x); t.y = __builtin_amdgcn_rcpf(d.y);
    f32x2 q = t * 0.5307027145f + (-0.7265760135f); q = q * t + 0.7107068705f; q = q * t + (-0.142248368f); q = q * t + 0.127414796f; q = q * t;
    const f32x2 s = (v * v) * (-0.72134752044f);
    f32x2 e; e.x = __builtin_amdgcn_exp2f(s.x); e.y = __builtin_amdgcn_exp2f(s.y);
    const f32x2 m = v * (q * e), r = v - m;
    f32x2 o; o.x = v.x < 0.f ? m.x : r.x; o.y = v.y < 0.f ? m.y : r.y; return o;
}

template <int ACT  > struct EpiBf16 {
    static constexpr bool PERM = true, AFTER_DRAIN = false; static_assert(ACT == 0 || ACT == 1, "EpiBf16: ACT is 0 (none) or 1 (gelu_pk)");
    bf16_t* O; int ldc; const float* bias; int split_cols; size_t split_stride; float scale0;
    __device__ __forceinline__ void operator()(const f32x4 (&acc)[2][2][4][2], const Unit& u, int wr, int wc, int fr, int fq) const {
        const int row0 = u.pm * BM + wr * 64 + fr; int colt = u.pn * BM; bf16_t* base = O;
        float sc = 1.f; if (split_cols) { const int t = colt / split_cols; base += (size_t)t * split_stride; colt -= t * split_cols; if (t == 0) sc = scale0; }
        const int col0 = colt + wc * 32 + 8 * fq, bcol0 = u.pn * BM + wc * 32 + 8 * fq;
        f32x4 bv[2][2];
#pragma unroll
        for (int bj = 0; bj < 2; ++bj)
#pragma unroll
            for (int n = 0; n < 2; ++n) bv[bj][n] = bias ? *(const f32x4*)(bias + bcol0 + bj * HALF + 4 * n) : (f32x4){0.f, 0.f, 0.f, 0.f};
#pragma unroll
        for (int ai = 0; ai < 2; ++ai)
#pragma unroll
            for (int m = 0; m < 4; ++m) { bf16_t* rowp = base + (size_t)(row0 + ai * HALF + m * 16) * ldc + col0;
#pragma unroll
                for (int bj = 0; bj < 2; ++bj) { f32x4 v0 = acc[ai][bj][m][0] + bv[bj][0], v1 = acc[ai][bj][m][1] + bv[bj][1];
                    if (ACT == 1) { f32x2 a = gelu_pk((f32x2){v0[0], v0[1]}), b = gelu_pk((f32x2){v0[2], v0[3]}), c = gelu_pk((f32x2){v1[0], v1[1]}), d = gelu_pk((f32x2){v1[2], v1[3]});
                        v0 = (f32x4){a.x, a.y, b.x, b.y}; v1 = (f32x4){c.x, c.y, d.x, d.y}; }
                    v0 = v0 * sc; v1 = v1 * sc; u32x4 w; w.x = cvt_pk_bf16(v0[0], v0[1]); w.y = cvt_pk_bf16(v0[2], v0[3]); w.z = cvt_pk_bf16(v1[0], v1[1]); w.w = cvt_pk_bf16(v1[2], v1[3]);
                    *(u32x4*)(rowp + bj * HALF) = w; } }
    }
};

typedef unsigned u32x2 __attribute__((ext_vector_type(2)));
struct EpiRowScaleBf16 {
    static constexpr bool PERM = true, AFTER_DRAIN = false;
    bf16_t* O; int ldc; const PG8_LAS float* rs;
    __device__ __forceinline__ void operator()(const f32x4 (&acc)[2][2][4][2], const Unit& u, int wr, int wc, int fr, int fq) const {
        const int col0 = u.pn * BM + wc * 32 + 8 * fq;
#pragma unroll
        for (int ai = 0; ai < 2; ++ai)
#pragma unroll
            for (int m = 0; m < 4; ++m) { const int rl = ai * HALF + wr * 64 + m * 16 + fr; const float s = rs[rl]; bf16_t* rowp = O + (size_t)(u.pm * BM + rl) * ldc + col0;
#pragma unroll
                for (int bj = 0; bj < 2; ++bj) { const f32x4 v0 = acc[ai][bj][m][0] * s, v1 = acc[ai][bj][m][1] * s;
                    u32x4 w; w.x = cvt_pk_bf16(v0[0], v0[1]); w.y = cvt_pk_bf16(v0[2], v0[3]); w.z = cvt_pk_bf16(v1[0], v1[1]); w.w = cvt_pk_bf16(v1[2], v1[3]);
                    *(u32x4*)(rowp + bj * HALF) = w; } }
    }
};
struct EpiResidual {
    static constexpr bool PERM = false, AFTER_DRAIN = false;
    const float* X; float* H; bf16_t* Hb; float* part; int ldc;
    __device__ __forceinline__ void operator()(const f32x4 (&acc)[2][2][4][2], const Unit& u, int wr, int wc, int fr, int fq) const {
        const int col0 = u.pn * BM + wc * 32 + 4 * fq;
#pragma unroll
        for (int ai = 0; ai < 2; ++ai)
#pragma unroll
            for (int m = 0; m < 4; ++m) { const int r = u.pm * BM + ai * HALF + wr * 64 + m * 16 + fr; const size_t off = (size_t)r * ldc + col0; float ss = 0.f;
#pragma unroll
                for (int bj = 0; bj < 2; ++bj)
#pragma unroll
                    for (int n = 0; n < 2; ++n) { const size_t o = off + bj * HALF + n * 16; const f32x4 v = acc[ai][bj][m][n] + *(const f32x4*)(X + o);
                        *(f32x4*)(H + o) = v; u32x2 w; w.x = cvt_pk_bf16(v[0], v[1]); w.y = cvt_pk_bf16(v[2], v[3]); *(u32x2*)(Hb + o) = w;
                        ss += (v[0] * v[0] + v[1] * v[1]) + (v[2] * v[2] + v[3] * v[3]); }
                ss += __shfl_xor(ss, 16); ss += __shfl_xor(ss, 32);
                if (fq == 0) part[(size_t)r * 32 + u.pn * 4 + wc] = ss; }
    }
};
struct EpiGate {
    static constexpr bool PERM = false, AFTER_DRAIN = false;
    const float* H2; const bf16_t* PP; float* OUT; float* part; int ldc;
    __device__ __forceinline__ void operator()(const f32x4 (&acc)[2][2][4][2], const Unit& u, int wr, int wc, int fr, int fq) const {
        const int col0 = u.pn * BM + wc * 32 + 4 * fq;
#pragma unroll
        for (int ai = 0; ai < 2; ++ai)
#pragma unroll
            for (int m = 0; m < 4; ++m) { const int r = u.pm * BM + ai * HALF + wr * 64 + m * 16 + fr; const size_t off = (size_t)r * ldc + col0; float ss = 0.f;
#pragma unroll
                for (int bj = 0; bj < 2; ++bj)
#pragma unroll
                    for (int n = 0; n < 2; ++n) { const size_t o = off + bj * HALF + n * 16; const f32x4 a = acc[ai][bj][m][n]; const f32x4 hv = *(const f32x4*)(H2 + o); const u32x2 pw = *(const u32x2*)(PP + o);
                        f32x4 pp; pp[0] = __uint_as_float(pw.x << 16); pp[1] = __uint_as_float(pw.x & 0xffff0000u); pp[2] = __uint_as_float(pw.y << 16); pp[3] = __uint_as_float(pw.y & 0xffff0000u);
                        f32x4 v;
#pragma unroll
                        for (int i = 0; i < 4; ++i) v[i] = hv[i] + pp[i] / (1.0f + __expf(-a[i]));
                        *(f32x4*)(OUT + o) = v;
                        ss += (v[0] * v[0] + v[1] * v[1]) + (v[2] * v[2] + v[3] * v[3]); }
                ss += __shfl_xor(ss, 16); ss += __shfl_xor(ss, 32);
                if (fq == 0) part[(size_t)r * 32 + u.pn * 4 + wc] = ss; }
    }
};
template <class Epi, class Sched, bool ALIGN_EPI = false, bool SP2 = false>
__device__ __forceinline__ void gemm_phase(PG8_LAS unsigned char* lds, const Gemm g, const Sched& S, const Epi& E) {
    int tid_o = threadIdx.x; asm volatile("" : "+v"(tid_o));
    const int tid = tid_o, wid = __builtin_amdgcn_readfirstlane(tid >> 6), lane = tid & 63, wr = wid >> 2, wc = wid & 3, fr = lane & 15, fq = lane >> 4;
    const int K = g.K, nt = K / BK;
    unsigned voffA[2], voffB[2];
#pragma unroll
    for (int i = 0; i < 2; ++i) { int R, C; stage_rc(tid * 16 + i * 8192, R, C); const int Rb = Epi::PERM ? ((R & ~31) + perm32(R & 31)) : R;
        voffA[i] = (unsigned)(R * K + C) * 2u; voffB[i] = (unsigned)(Rb * K + C) * 2u; }
    const size_t kstep = (size_t)(BK * 2);
    const size_t hstep = (size_t)HALF * K * 2;
    const size_t tstep = 2 * hstep;
    const unsigned ldsw = (unsigned)wid * 1024u;
    const int aoff = lds_byte(wr * 64 + fr, fq * 8), boff = lds_byte(wc * 32 + fr, fq * 8);
#define PG8_SA(b, h) (((b) * 2 + (h)) * HTB)
#define PG8_SB(b, h) ((4 + (b) * 2 + (h)) * HTB)
#define PG8_STAGE(bufoff, gbase, voff) do { _Pragma("unroll") for (int _i = 0; _i < 2; ++_i) \
        __builtin_amdgcn_global_load_lds((const unsigned*)((const char*)(gbase) + (voff)[_i]), (PG8_LAS unsigned*)(lds + (bufoff) + ldsw + _i * 8192), 16, 0, 0); } while (0)
#define PG8_LDA(dst, b, h) do { _Pragma("unroll") for (int m = 0; m < 4; ++m) _Pragma("unroll") for (int k = 0; k < 2; ++k) dst[m][k] = *(const PG8_LAS bf16x8*)(lds + PG8_SA(b, h) + aoff + m * 2048 + k * 1024); } while (0)
#define PG8_LDB(dst, b, h) do { _Pragma("unroll") for (int n = 0; n < 2; ++n) _Pragma("unroll") for (int k = 0; k < 2; ++k) dst[n][k] = *(const PG8_LAS bf16x8*)(lds + PG8_SB(b, h) + boff + n * 2048 + k * 1024); } while (0)
#define PG8_MMA(ai, bj, At, Bt) do { __builtin_amdgcn_s_setprio(1); _Pragma("unroll") for (int m = 0; m < 4; ++m) _Pragma("unroll") for (int n = 0; n < 2; ++n) _Pragma("unroll") for (int k = 0; k < 2; ++k) \
        acc[ai][bj][m][n] = __builtin_amdgcn_mfma_f32_16x16x32_bf16(Bt[n][k], At[m][k], acc[ai][bj][m][n], 0, 0, 0); __builtin_amdgcn_s_setprio(0); } while (0)
#define PG8_WAIT_V(n) asm volatile("s_waitcnt vmcnt(" #n ")" ::: "memory")
#define PG8_WAIT_L(n) asm volatile("s_waitcnt lgkmcnt(" #n ")" ::: "memory")
#define PG8_BAR __builtin_amdgcn_s_barrier()
#define PG8_SCHED __builtin_amdgcn_sched_barrier(0)
    Unit cur, nxt; int ui = 0;
    if (!S.next(0, cur)) return;
    f32x4 acc[2][2][4][2];
#pragma unroll
    for (int a = 0; a < 2; ++a)
#pragma unroll
        for (int b = 0; b < 2; ++b)
#pragma unroll
            for (int m = 0; m < 4; ++m)
#pragma unroll
                for (int n = 0; n < 2; ++n) acc[a][b][m][n] = (f32x4){0.f, 0.f, 0.f, 0.f};
    bf16x8 At[4][2], B0[2][2], B1[2][2];
    const char* cA = (const char*)g.A + (size_t)cur.pm * tstep; const char* cB = (const char*)g.Bt + (size_t)cur.pn * tstep;
    S.a_ready(cur);
    if constexpr (SP2) {
        PG8_STAGE(PG8_SB(0, 0), cB, voffB); PG8_STAGE(PG8_SB(0, 1), cB + hstep, voffB); PG8_STAGE(PG8_SA(0, 0), cA, voffA); PG8_STAGE(PG8_SA(0, 1), cA + hstep, voffA);
        if (wr == 1) PG8_BAR;
        PG8_WAIT_V(2); PG8_BAR;
        PG8_STAGE(PG8_SB(1, 0), cB + kstep, voffB); PG8_STAGE(PG8_SA(1, 0), cA + kstep, voffA); PG8_STAGE(PG8_SB(1, 1), cB + hstep + kstep, voffB);
        PG8_WAIT_V(6); PG8_BAR;
    } else {
        PG8_STAGE(PG8_SB(0, 0), cB, voffB); PG8_STAGE(PG8_SA(0, 0), cA, voffA); PG8_STAGE(PG8_SB(0, 1), cB + hstep, voffB); PG8_STAGE(PG8_SA(0, 1), cA + hstep, voffA);
        if (wr == 1) PG8_BAR;
        PG8_WAIT_V(4); PG8_BAR;
        PG8_STAGE(PG8_SB(1, 0), cB + kstep, voffB); PG8_STAGE(PG8_SA(1, 0), cA + kstep, voffA); PG8_STAGE(PG8_SB(1, 1), cB + hstep + kstep, voffB);
        PG8_WAIT_V(6); PG8_BAR;
    }
    for (;;) {
        const bool has_next = S.next(ui + 1, nxt);
        const char* nA = has_next ? (const char*)g.A + (size_t)nxt.pm * tstep : cA; const char* nB = has_next ? (const char*)g.Bt + (size_t)nxt.pn * tstep : cB;
        for (int t = 0; t < nt; t += 2) {
            const bool last = (t == nt - 2);
            const char* a1 = cA + (size_t)(t + 1) * kstep;
            const char* a2 = last ? nA : cA + (size_t)(t + 2) * kstep; const char* b2 = last ? nB : cB + (size_t)(t + 2) * kstep;
            const char* a3 = a2 + kstep; const char* b3 = b2 + kstep;
            if (last && has_next) S.a_ready(nxt);
            if constexpr (SP2) {
            PG8_LDB(B0, 0, 0); PG8_LDB(B1, 0, 1); PG8_SCHED; PG8_LDA(At, 0, 0); PG8_STAGE(PG8_SA(1, 1), a1 + hstep, voffA);
            PG8_WAIT_V(8); PG8_WAIT_L(0); PG8_BAR; PG8_MMA(0, 0, At, B0); PG8_MMA(0, 1, At, B1); PG8_BAR; PG8_SCHED;
            PG8_LDA(At, 0, 1); PG8_STAGE(PG8_SB(0, 0), b2, voffB); PG8_STAGE(PG8_SB(0, 1), b2 + hstep, voffB); PG8_STAGE(PG8_SA(0, 0), a2, voffA);
            PG8_WAIT_V(8); PG8_WAIT_L(0); PG8_BAR; PG8_MMA(1, 0, At, B0); PG8_MMA(1, 1, At, B1); PG8_BAR; PG8_SCHED;
            PG8_LDB(B0, 1, 0); PG8_LDB(B1, 1, 1); PG8_SCHED; PG8_LDA(At, 1, 0); PG8_STAGE(PG8_SA(0, 1), a2 + hstep, voffA);
            PG8_WAIT_V(8); PG8_WAIT_L(0); PG8_BAR; PG8_MMA(0, 0, At, B0); PG8_MMA(0, 1, At, B1); PG8_BAR; PG8_SCHED;
            PG8_LDA(At, 1, 1); PG8_STAGE(PG8_SB(1, 0), b3, voffB); PG8_STAGE(PG8_SB(1, 1), b3 + hstep, voffB); PG8_STAGE(PG8_SA(1, 0), a3, voffA);
            PG8_WAIT_V(8); PG8_WAIT_L(0); PG8_BAR; PG8_MMA(1, 0, At, B0); PG8_MMA(1, 1, At, B1); PG8_BAR; PG8_SCHED;
            } else {
            PG8_LDB(B0, 0, 0); PG8_SCHED; PG8_LDA(At, 0, 0); PG8_STAGE(PG8_SA(1, 1), a1 + hstep, voffA);
            PG8_WAIT_L(8); PG8_BAR; PG8_WAIT_L(0); PG8_MMA(0, 0, At, B0); PG8_BAR; PG8_SCHED;
            PG8_LDB(B1, 0, 1); PG8_STAGE(PG8_SB(0, 0), b2, voffB);
            PG8_BAR; PG8_WAIT_L(0); PG8_MMA(0, 1, At, B1); PG8_BAR;
            PG8_LDA(At, 0, 1); PG8_STAGE(PG8_SA(0, 0), a2, voffA);
            PG8_BAR; PG8_WAIT_L(0); PG8_MMA(1, 0, At, B0); PG8_BAR; PG8_SCHED;
            PG8_STAGE(PG8_SB(0, 1), b2 + hstep, voffB);
            PG8_WAIT_V(6); PG8_BAR; PG8_MMA(1, 1, At, B1); PG8_BAR;
            PG8_LDB(B0, 1, 0); PG8_SCHED; PG8_LDA(At, 1, 0); PG8_STAGE(PG8_SA(0, 1), a2 + hstep, voffA);
            PG8_WAIT_L(8); PG8_BAR; PG8_WAIT_L(0); PG8_MMA(0, 0, At, B0); PG8_BAR; PG8_SCHED;
            PG8_LDB(B1, 1, 1); PG8_STAGE(PG8_SB(1, 0), b3, voffB);
            PG8_BAR; PG8_WAIT_L(0); PG8_MMA(0, 1, At, B1); PG8_BAR;
            PG8_LDA(At, 1, 1); PG8_STAGE(PG8_SA(1, 0), a3, voffA);
            PG8_BAR; PG8_WAIT_L(0); PG8_MMA(1, 0, At, B0); PG8_BAR; PG8_SCHED;
            PG8_STAGE(PG8_SB(1, 1), b3 + hstep, voffB);
            PG8_WAIT_V(6); PG8_BAR; PG8_MMA(1, 1, At, B1); PG8_BAR;
            }
        }
        if constexpr (ALIGN_EPI) { if (wr == 0) PG8_BAR; }
        if constexpr (!Epi::AFTER_DRAIN) { E(acc, cur, wr, wc, fr, fq); S.done(cur); }
        if (!has_next) break;
#pragma unroll
        for (int a = 0; a < 2; ++a)
#pragma unroll
            for (int b = 0; b < 2; ++b)
#pragma unroll
                for (int m = 0; m < 4; ++m)
#pragma unroll
                    for (int n = 0; n < 2; ++n) acc[a][b][m][n] = (f32x4){0.f, 0.f, 0.f, 0.f};
        cur = nxt; cA = nA; cB = nB; ++ui;
        if constexpr (ALIGN_EPI) { if (wr == 1) PG8_BAR; }
    }
    PG8_WAIT_V(0);
    if constexpr (!ALIGN_EPI) { if (wr == 0) PG8_BAR; }
    PG8_BAR;
    if constexpr (Epi::AFTER_DRAIN) { E.fused(acc, cur, wr, wc, fr, fq, lds, wid, lane); S.done(cur); }
#undef PG8_SA
#undef PG8_SB
#undef PG8_STAGE
#undef PG8_LDA
#undef PG8_LDB
#undef PG8_MMA
#undef PG8_WAIT_V
#undef PG8_WAIT_L
#undef PG8_BAR
#undef PG8_SCHED
}
}

constexpr int NWAVES = 8, NTHR = NWAVES * 64;
constexpr int NT = 8192, DM = 2048, SEQ = 2048, NB = 4;
constexpr int INC = 7176, PROJW = 7168;
constexpr int NEXP = 16384;
constexpr float EPS = 1e-6f;
constexpr size_t MiB = 1u << 20;
constexpr size_t WS_CTL = 0, CTL_ZERO_BYTES = 1 * MiB;
constexpr size_t WS_WIN = 2 * MiB, WS_WOUT = 30 * MiB, WS_WQ = 38 * MiB, WS_WG = 46 * MiB, WS_WP = 54 * MiB, WS_KEYS = 55 * MiB, WS_P16 = 56 * MiB;
constexpr size_t WS_GI = 60 * MiB, WS_BLOC = 61 * MiB, WS_MT = 61 * MiB + 512 * 1024, WS_SCAL = 62 * MiB, WS_LBUF = 62 * MiB + 256 * 1024, WS_NBUF = 62 * MiB + 512 * 1024;
constexpr size_t WS_PART = 63 * MiB, WS_PART2 = 64 * MiB, WS_IDX = 65 * MiB, WS_GW = 69 * MiB;
constexpr size_t WS_U16 = 80 * MiB, WS_V16 = 144 * MiB;
constexpr size_t WS_XN = 208 * MiB;
constexpr size_t WS_PROJ = 240 * MiB, WS_PP = 352 * MiB;
constexpr size_t WS_Y = 384 * MiB;
constexpr size_t WS_UBUF = 416 * MiB;
constexpr size_t WS_END = 480 * MiB;
constexpr int CW_BAR = 4096;
constexpr int LDS_BYTES = 147456;
constexpr int R0_OFF = 0, R1_OFF = 69632, ARR_OFF = 139264, RS_OFF = 145408, MISC_OFF = 146432;

#define GAS __attribute__((address_space(1)))
#define LAS __attribute__((address_space(3)))
typedef unsigned short bf16;
typedef unsigned v4u __attribute__((ext_vector_type(4)));
typedef unsigned v2u __attribute__((ext_vector_type(2)));
typedef float f32x4 __attribute__((ext_vector_type(4)));
typedef short bf16x8 __attribute__((ext_vector_type(8)));
#define LDS_WAIT() asm volatile("s_waitcnt lgkmcnt(0)" ::: "memory")
__device__ __forceinline__ unsigned f2bf(float f) { unsigned u = __builtin_bit_cast(unsigned, f); return (u + 0x7fffu + ((u >> 16) & 1u)) >> 16; }
__device__ __forceinline__ unsigned pk2(float lo, float hi) { return f2bf(lo) | (f2bf(hi) << 16); }
__device__ __forceinline__ float bflo(unsigned w) { return __uint_as_float(w << 16); }
__device__ __forceinline__ float bfhi(unsigned w) { return __uint_as_float(w & 0xffff0000u); }
__device__ __forceinline__ float wave_sum(float v) {
#pragma unroll
    for (int o = 1; o < 64; o <<= 1) v += __shfl_xor(v, o);
    return v;
}

#define XB_TMO      128
#define XB_XCNT(j)  (256  + 64 * (j))
#define XB_XSUB(j)  (1280 + 64 * (j))
#define XB_XGEN(j)  (2304 + 64 * (j))
#define XB_TOP      3328
#define XB_TOPGEN   3392
#define XCD_BAR_WORDS 3456
#define XB_SPIN_CAP (1u << 18)
__device__ __forceinline__ unsigned xb_ld(unsigned* p)              { return __hip_atomic_load(p, __ATOMIC_RELAXED, __HIP_MEMORY_SCOPE_AGENT); }
__device__ __forceinline__ unsigned xb_add(unsigned* p, unsigned v) { return __hip_atomic_fetch_add(p, v, __ATOMIC_RELAXED, __HIP_MEMORY_SCOPE_AGENT); }
__device__ __forceinline__ unsigned xb_xcc_id() { return (unsigned)__builtin_amdgcn_s_getreg((3 << 11) | 20) & 0xFu; }
#define XB_SPIN(cond, bar) do { unsigned _sp = 0; while (cond) { __builtin_amdgcn_s_sleep(1); \
    if ((++_sp & 255u) == 0u) { if (xb_ld(&(bar)[XB_TMO])) break; if (_sp > XB_SPIN_CAP) { atomicAdd(&(bar)[XB_TMO], 1u); break; } } } } while (0)
struct XcdBarrier { unsigned* bar; unsigned x; volatile LAS unsigned* st; };
__device__ __forceinline__ XcdBarrier xcd_barrier_post(unsigned* bar, volatile LAS unsigned* st) {
    XcdBarrier b; b.bar = bar; b.x = xb_xcc_id(); b.st = st;
    if (threadIdx.x == 0) (void)xb_add(&bar[XB_XCNT(b.x)], 1u);
    return b;
}
__device__ __forceinline__ void xcd_barrier_complete(unsigned* bar, unsigned x, unsigned& nloc, unsigned& nx) {
    const unsigned G = gridDim.x * gridDim.y * gridDim.z;
    unsigned sum, cnt, mine, sp = 0u;
    for (;;) {
        sum = 0u; cnt = 0u; mine = 0u;
#pragma unroll
        for (unsigned j = 0; j < 16; ++j) { const unsigned c = xb_ld(&bar[XB_XCNT(j)]); sum += c; cnt += (c > 0u) ? 1u : 0u; mine = (j == x) ? c : mine; }
        if (sum == G) break;
        __builtin_amdgcn_s_sleep(1);
        if ((++sp & 255u) == 0u) { if (xb_ld(&bar[XB_TMO])) break; if (sp > XB_SPIN_CAP) { atomicAdd(&bar[XB_TMO], 1u); break; } }
    }
    nloc = mine > 0u ? mine : 1u; nx = cnt > 0u ? cnt : 1u;
}
__device__ __forceinline__ void xcd_barrier(const XcdBarrier& b) {
    asm volatile("s_waitcnt vmcnt(0)" ::: "memory");
    __syncthreads();
    if (threadIdx.x == 0) {
        unsigned* bar = b.bar;
        __builtin_amdgcn_s_waitcnt(0);
        unsigned nloc = b.st[0], nx = b.st[1];
        if (nloc == 0u) { xcd_barrier_complete(bar, b.x, nloc, nx); b.st[0] = nloc; b.st[1] = nx; }
        const unsigned old = xb_add(&bar[XB_XSUB(b.x)], 1u);
        const unsigned gen = old / nloc;
        if (old + 1u == (gen + 1u) * nloc) {
            __builtin_amdgcn_fence(__ATOMIC_RELEASE, "agent");
            asm volatile("s_waitcnt vmcnt(0)" ::: "memory");
            const unsigned og = xb_add(&bar[XB_TOP], 1u);
            const unsigned tg = og / nx;
            if (og + 1u == (tg + 1u) * nx) xb_add(&bar[XB_TOPGEN], 1u);
            else XB_SPIN(xb_ld(&bar[XB_TOPGEN]) == tg, bar);
            __builtin_amdgcn_fence(__ATOMIC_ACQUIRE, "agent");
            xb_add(&bar[XB_XGEN(b.x)], 1u);
            asm volatile("s_waitcnt vmcnt(0)" ::: "memory");
        } else {
            XB_SPIN(xb_ld(&bar[XB_XGEN(b.x)]) == gen, bar);
            __builtin_amdgcn_fence(__ATOMIC_ACQUIRE, "agent");
            asm volatile("s_waitcnt vmcnt(0)" ::: "memory");
        }
    }
    __syncthreads();
}

struct Args { const float* in[17]; float* out; unsigned char* ws; unsigned long long pad; };

__device__ __forceinline__ void p0_transpose_item(const float* W, int ldw, int K, bf16* WT, int nblk, int item, LAS float* scr, int lane, const float* kscale) {
    const int kb = item / nblk, nb = item % nblk, k0 = 64 * kb, n0 = 32 * nb;
#pragma unroll 8
    for (int i = 0; i < 32; ++i) { const int kk = 2 * i + (lane >> 5); float v = W[(size_t)(k0 + kk) * ldw + n0 + (lane & 31)]; if (kscale) v *= kscale[k0 + kk]; scr[kk * 33 + (lane & 31)] = v; }
    LDS_WAIT(); asm volatile("" ::: "memory");
    const int c = lane & 7;
#pragma unroll
    for (int j = 0; j < 4; ++j) { const int n = (lane >> 3) + 8 * j; const LAS float* s = scr + (8 * c) * 33 + n;
        v4u o; o.x = pk2(s[0 * 33], s[1 * 33]); o.y = pk2(s[2 * 33], s[3 * 33]); o.z = pk2(s[4 * 33], s[5 * 33]); o.w = pk2(s[6 * 33], s[7 * 33]);
        *(GAS v4u*)(WT + (size_t)(n0 + n) * K + k0 + 8 * c) = o; }
    LDS_WAIT(); asm volatile("" ::: "memory");
}
__device__ __forceinline__ void cvt_stream(const float* src, bf16* dst, size_t n8, size_t gtid, size_t nthr) {
    for (size_t i = gtid; i < n8; i += nthr) { const f32x4 a = ((const GAS f32x4*)src)[2 * i], b = ((const GAS f32x4*)src)[2 * i + 1];
        v4u o; o.x = pk2(a.x, a.y); o.y = pk2(a.z, a.w); o.z = pk2(b.x, b.y); o.w = pk2(b.z, b.w); ((GAS v4u*)dst)[i] = o; }
}
__device__ __forceinline__ float log_sigmoid(float x) { return fminf(x, 0.f) - log1pf(expf(-fabsf(x))); }

__device__ __forceinline__ void phase0(const Args& A, LAS unsigned char* lds, int tid, int lane, int wave) {
    unsigned char* ws = A.ws;
    const int G = gridDim.x, gw = blockIdx.x * NWAVES + wave, NGW = G * NWAVES;
    const size_t gtid = (size_t)blockIdx.x * NTHR + tid, nthr = (size_t)G * NTHR;
    {
        LAS float* scr = (LAS float*)(lds + wave * 16384);
        constexpr int I_IN = 32 * 224, I_SQ = 32 * 64, I_P = 4 * 64;
        constexpr int NITEMS = I_IN + 3 * I_SQ + I_P;
        for (int it = gw; it < NITEMS; it += NGW) {
            int r = it;
            if (r < I_IN) { p0_transpose_item(A.in[3], INC, DM, (bf16*)(ws + WS_WIN), 224, r, scr, lane, nullptr); continue; } r -= I_IN;
            if (r < I_SQ) { p0_transpose_item(A.in[7], DM, DM, (bf16*)(ws + WS_WOUT), 64, r, scr, lane, nullptr); continue; } r -= I_SQ;
            if (r < I_SQ) { p0_transpose_item(A.in[9], DM, DM, (bf16*)(ws + WS_WQ), 64, r, scr, lane, A.in[8]); continue; } r -= I_SQ;
            if (r < I_SQ) { p0_transpose_item(A.in[14], DM, DM, (bf16*)(ws + WS_WG), 64, r, scr, lane, nullptr); continue; } r -= I_SQ;
            p0_transpose_item(A.in[15], DM, 256, (bf16*)(ws + WS_WP), 64, r, scr, lane, nullptr);
        }
    }
    cvt_stream(A.in[10], (bf16*)(ws + WS_KEYS), (size_t)8 * 2 * 128 * 128 / 8, gtid, nthr);
    cvt_stream(A.in[1], (bf16*)(ws + WS_P16), (size_t)NT * 256 / 8, gtid, nthr);
    cvt_stream(A.in[11], (bf16*)(ws + WS_U16), (size_t)NEXP * DM / 8, gtid, nthr);
    cvt_stream(A.in[12], (bf16*)(ws + WS_V16), (size_t)NEXP * DM / 8, gtid, nthr);
    __syncthreads();
    LAS float* wg8 = (LAS float*)lds;
    for (int i = tid; i < DM * 8; i += NTHR) wg8[i] = A.in[3][(size_t)(i >> 3) * INC + PROJW + (i & 7)];
    __syncthreads();
    {
        const float* x = A.in[0]; const float* g = A.in[2]; const float* gb = A.in[5];
        bf16* XN = (bf16*)(ws + WS_XN); float* GI = (float*)(ws + WS_GI);
        f32x4 gv[8];
#pragma unroll
        for (int j = 0; j < 8; ++j) gv[j] = ((const GAS f32x4*)g)[lane + 64 * j];
        for (int t = gw; t < NT; t += NGW) {
            const GAS f32x4* xr = (const GAS f32x4*)(x + (size_t)t * DM) + lane;
            f32x4 v[8]; float ss = 0.f;
#pragma unroll
            for (int j = 0; j < 8; ++j) { v[j] = xr[64 * j]; ss += (v[j].x * v[j].x + v[j].y * v[j].y) + (v[j].z * v[j].z + v[j].w * v[j].w); }
            const float rstd = 1.0f / sqrtf(wave_sum(ss) * (1.0f / DM) + EPS);
            float ga[8];
#pragma unroll
            for (int c = 0; c < 8; ++c) ga[c] = 0.f;
            GAS v2u* o8 = (GAS v2u*)(XN + (size_t)t * DM) + lane;
#pragma unroll
            for (int j = 0; j < 8; ++j) {
                f32x4 xn = v[j] * rstd * gv[j];
                v2u o; o.x = pk2(xn.x, xn.y); o.y = pk2(xn.z, xn.w); o8[64 * j] = o;
#pragma unroll
                for (int i = 0; i < 4; ++i) { const int e = 4 * lane + 256 * j + i; const f32x4 w0 = *(const LAS f32x4*)(wg8 + e * 8), w1 = *(const LAS f32x4*)(wg8 + e * 8 + 4); const float xv = xn[i];
                    ga[0] += xv * w0.x; ga[1] += xv * w0.y; ga[2] += xv * w0.z; ga[3] += xv * w0.w; ga[4] += xv * w1.x; ga[5] += xv * w1.y; ga[6] += xv * w1.z; ga[7] += xv * w1.w; }
                asm volatile("" ::: "memory");
            }
            float outv = 0.f;
#pragma unroll
            for (int c = 0; c < 8; ++c) { const float s = wave_sum(ga[c]); if (lane == c) outv = s; }
            if (lane < 8) { float val = outv + gb[lane]; if (lane >= 4) val = log_sigmoid(val); GI[(size_t)t * 8 + lane] = val; }
        }
    }
}

constexpr int TRS = 272;
constexpr int NRS = 528;
constexpr int A_BL = 0, A_PML = 16, A_BS = 32, A_IS = 160, A_PMS = 288, A_WV = 416, A_MT = 544, A_NL = 672;

__device__ __forceinline__ void phase_x1(const Args& A, LAS unsigned char* lds, int tid, int lane, int wave) {
    unsigned char* ws = A.ws;
    const float* GI = (const float*)(ws + WS_GI); const bf16* PROJ = (const bf16*)(ws + WS_PROJ);
    float* BLOC = (float*)(ws + WS_BLOC); float* MT = (float*)(ws + WS_MT); float* SCAL = (float*)(ws + WS_SCAL); float* LBUF = (float*)(ws + WS_LBUF); float* UBUF = (float*)(ws + WS_UBUF);
    LAS float* arr = (LAS float*)(lds + ARR_OFF);
    const int lm = lane & 15, g = lane >> 4;
    for (int u = blockIdx.x; u < 256; u += gridDim.x) {
        const int c = u & 15, h = (u >> 4) & 3, b = u >> 6;
        const int t0 = b * SEQ + c * 128;
        __syncthreads();
#pragma unroll
        for (int rep = 0; rep < 2; ++rep) {
            const int cc = wave + 8 * rep;
            if (cc <= c) {
                const size_t tt = (size_t)(b * SEQ + cc * 128 + 2 * lane);
                const float i0 = GI[tt * 8 + h], i1 = GI[(tt + 1) * 8 + h], lf0 = GI[tt * 8 + 4 + h], lf1 = GI[(tt + 1) * 8 + 4 + h];
                const float p = lf0 + lf1; float incl = p;
#pragma unroll
                for (int o = 1; o < 64; o <<= 1) { const float y = __shfl_up(incl, o); if (lane >= o) incl += y; }
                const float excl = incl - p, b0 = excl + lf0, b1 = incl;
                const float g0 = i0 - b0, g1 = i1 - b1, q = fmaxf(g0, g1); float im = q;
#pragma unroll
                for (int o = 1; o < 64; o <<= 1) { const float y = __shfl_up(im, o); if (lane >= o) im = fmaxf(im, y); }
                float em = __shfl_up(im, 1); if (lane == 0) em = -INFINITY;
                if (lane == 63) { arr[A_BL + cc] = incl; arr[A_PML + cc] = im; }
                if (cc == c) { arr[A_BS + 2 * lane] = b0; arr[A_BS + 2 * lane + 1] = b1; arr[A_IS + 2 * lane] = i0; arr[A_IS + 2 * lane + 1] = i1;
                    arr[A_PMS + 2 * lane] = fmaxf(em, g0); arr[A_PMS + 2 * lane + 1] = im; }
            }
        }
        __syncthreads();
        float mprev = 0.f;
        for (int cc = 0; cc < c; ++cc) mprev = arr[A_BL + cc] + fmaxf(mprev, arr[A_PML + cc]);
        const float blast = arr[A_BL + c];
        const float mnew = arr[A_BS + 127] + fmaxf(mprev, arr[A_PMS + 127]);
        if (tid < 128) {
            const float bt = arr[A_BS + tid], mt = bt + fmaxf(mprev, arr[A_PMS + tid]);
            arr[A_WV + tid] = expf(blast - bt + arr[A_IS + tid] - mnew) * 0.0625f;
            BLOC[(size_t)(t0 + tid) * 4 + h] = bt; MT[(size_t)(t0 + tid) * 4 + h] = mt;
        }
        if (tid == 0) { SCAL[u * 4 + 0] = expf(blast + mprev - mnew); SCAL[u * 4 + 1] = mprev; }
        __syncthreads();
#pragma unroll
        for (int it = 0; it < 4; ++it) {
            const int d0 = (wave * 4 + it) * 8;
            const bf16* r0p = PROJ + (size_t)(t0 + 2 * lane) * PROJW + h * 256 + d0;
            const v4u k0 = *(const GAS v4u*)(r0p + 4096), k1 = *(const GAS v4u*)(r0p + 4096 + PROJW);
            const v4u v0 = *(const GAS v4u*)(r0p + 5120), v1 = *(const GAS v4u*)(r0p + 5120 + PROJW);
            const float w0 = arr[A_WV + 2 * lane], w1 = arr[A_WV + 2 * lane + 1];
#pragma unroll
            for (int j = 0; j < 4; ++j) {
                const unsigned ka = k0[j], kb = k1[j], va = v0[j], vb = v1[j];
                *(LAS unsigned*)(lds + R0_OFF + (d0 + 2 * j) * TRS + 4 * lane) = (ka & 0xffffu) | (kb << 16);
                *(LAS unsigned*)(lds + R0_OFF + (d0 + 2 * j + 1) * TRS + 4 * lane) = (ka >> 16) | (kb & 0xffff0000u);
                *(LAS unsigned*)(lds + R1_OFF + (d0 + 2 * j) * TRS + 4 * lane) = pk2(bflo(va) * w0, bflo(vb) * w1);
                *(LAS unsigned*)(lds + R1_OFF + (d0 + 2 * j + 1) * TRS + 4 * lane) = pk2(bfhi(va) * w0, bfhi(vb) * w1);
            }
        }
        __syncthreads();
        if (tid < 256) {
            float s = 0.f;
#pragma unroll 4
            for (int s8 = 0; s8 < 16; ++s8) { const v4u kv = *(const LAS v4u*)(lds + R0_OFF + tid * TRS + s8 * 16);
#pragma unroll
                for (int j = 0; j < 4; ++j) s += bflo(kv[j]) * arr[A_WV + s8 * 8 + 2 * j] + bfhi(kv[j]) * arr[A_WV + s8 * 8 + 2 * j + 1]; }
            LBUF[u * 256 + tid] = s;
        }
        float* Uo = UBUF + (size_t)u * 65536;
#pragma unroll 1
        for (int dh = 0; dh < 2; ++dh) {
            f32x4 acc[2][8];
#pragma unroll
            for (int i = 0; i < 2; ++i)
#pragma unroll
                for (int j = 0; j < 8; ++j) acc[i][j] = (f32x4){0.f, 0.f, 0.f, 0.f};
#pragma unroll
            for (int kk = 0; kk < 4; ++kk) {
                bf16x8 af[2];
#pragma unroll
                for (int i = 0; i < 2; ++i) af[i] = *(const LAS bf16x8*)(lds + R1_OFF + (32 * wave + 16 * i + lm) * TRS + (32 * kk + 8 * g) * 2);
#pragma unroll
                for (int j = 0; j < 8; ++j) { const bf16x8 bfr = *(const LAS bf16x8*)(lds + R0_OFF + (128 * dh + 16 * j + lm) * TRS + (32 * kk + 8 * g) * 2);
#pragma unroll
                    for (int i = 0; i < 2; ++i) acc[i][j] = __builtin_amdgcn_mfma_f32_16x16x32_bf16(af[i], bfr, acc[i][j], 0, 0, 0); }
            }
#pragma unroll
            for (int i = 0; i < 2; ++i)
#pragma unroll
                for (int j = 0; j < 8; ++j)
#pragma unroll
                    for (int r = 0; r < 4; ++r) Uo[(size_t)(32 * wave + 16 * i + 4 * g + r) * 256 + 128 * dh + 16 * j + lm] = acc[i][j][r];
        }
    }
}

__device__ __forceinline__ void phase_x2(const Args& A, int tid) {
    unsigned char* ws = A.ws;
    const float* SCAL = (const float*)(ws + WS_SCAL); const float* LBUF = (const float*)(ws + WS_LBUF); const float* UBUF = (const float*)(ws + WS_UBUF);
    float* NBUF = (float*)(ws + WS_NBUF); bf16* CT = (bf16*)(ws + WS_XN);
    const bf16* PROJ = (const bf16*)(ws + WS_PROJ); bf16* Y = (bf16*)(ws + WS_Y);
    const size_t gtid = (size_t)blockIdx.x * NTHR + tid, nthr = (size_t)gridDim.x * NTHR;
    for (size_t it = gtid; it < (size_t)16 * 16384; it += nthr) {
        const int bh = (int)(it >> 14), r = (int)(it & 16383);
        f32x4 C = (f32x4){0.f, 0.f, 0.f, 0.f};
#pragma unroll 5
        for (int c = 0; c < 15; ++c) { const int u = bh * 16 + c; const float a = SCAL[u * 4];
            const f32x4 uv = *(const GAS f32x4*)(UBUF + (size_t)u * 65536 + (size_t)r * 4); C = C * a + uv;
            v2u o; o.x = pk2(C.x, C.y); o.y = pk2(C.z, C.w); *(GAS v2u*)(CT + (size_t)(u + 1) * 65536 + (size_t)r * 4) = o; }
    }
    for (size_t it = gtid; it < 4096; it += nthr) {
        const int bh = (int)(it >> 8), d = (int)(it & 255); float n = 0.f;
        for (int c = 0; c < 15; ++c) { const int u = bh * 16 + c; n = n * SCAL[u * 4] + LBUF[u * 256 + d]; NBUF[(u + 1) * 256 + d] = n; }
    }
    const float* cw = A.in[4];
    for (size_t it = gtid; it < (size_t)NT * 128; it += nthr) {
        const int t = (int)(it >> 7), c0 = (int)(it & 127) * 8, s = t & (SEQ - 1);
        const bf16* row = PROJ + (size_t)t * PROJW + c0;
        const v4u bc = *(const GAS v4u*)row, cc0 = *(const GAS v4u*)(row + 1024), uc0 = *(const GAS v4u*)(row + 2048);
        v4u cc1 = (v4u){0, 0, 0, 0}, uc1 = cc1, cc2 = cc1, uc2 = cc1;
        if (s >= 1) { cc1 = *(const GAS v4u*)(row - PROJW + 1024); uc1 = *(const GAS v4u*)(row - PROJW + 2048); }
        if (s >= 2) { cc2 = *(const GAS v4u*)(row - 2 * PROJW + 1024); uc2 = *(const GAS v4u*)(row - 2 * PROJW + 2048); }
        float w0[8], w1[8], w2[8];
#pragma unroll
        for (int i = 0; i < 8; ++i) { w0[i] = cw[c0 + i]; w1[i] = cw[1024 + c0 + i]; w2[i] = cw[2048 + c0 + i]; }
        v4u o;
#pragma unroll
        for (int j = 0; j < 4; ++j) {
            const float ylo = bflo(bc[j]) * (w0[2 * j] * (bflo(cc2[j]) * bflo(uc2[j])) + w1[2 * j] * (bflo(cc1[j]) * bflo(uc1[j])) + w2[2 * j] * (bflo(cc0[j]) * bflo(uc0[j])));
            const float yhi = bfhi(bc[j]) * (w0[2 * j + 1] * (bfhi(cc2[j]) * bfhi(uc2[j])) + w1[2 * j + 1] * (bfhi(cc1[j]) * bfhi(uc1[j])) + w2[2 * j + 1] * (bfhi(cc0[j]) * bfhi(uc0[j])));
            o[j] = pk2(ylo, yhi);
        }
        *(GAS v4u*)(Y + (size_t)t * DM + c0) = o;
    }
}

__device__ __forceinline__ void phase_x3(const Args& A, LAS unsigned char* lds, int tid, int lane, int wave) {
    unsigned char* ws = A.ws;
    const float* GI = (const float*)(ws + WS_GI); const bf16* PROJ = (const bf16*)(ws + WS_PROJ);
    const float* BLOC = (const float*)(ws + WS_BLOC); const float* MT = (const float*)(ws + WS_MT); const float* SCAL = (const float*)(ws + WS_SCAL); const float* NBUF = (const float*)(ws + WS_NBUF);
    const bf16* CT = (const bf16*)(ws + WS_XN); bf16* Y = (bf16*)(ws + WS_Y);
    const float* gm = A.in[6];
    LAS float* arr = (LAS float*)(lds + ARR_OFF);
    const int lm = lane & 15, g = lane >> 4;
    for (int u = blockIdx.x; u < 256; u += gridDim.x) {
        const int c = u & 15, h = (u >> 4) & 3, b = u >> 6;
        const int t0 = b * SEQ + c * 128;
        const float mprev = SCAL[u * 4 + 1];
        __syncthreads();
        if (tid < 128) { arr[A_BS + tid] = BLOC[(size_t)(t0 + tid) * 4 + h]; arr[A_MT + tid] = MT[(size_t)(t0 + tid) * 4 + h]; arr[A_IS + tid] = GI[(size_t)(t0 + tid) * 8 + h]; }
        if (tid < 256) arr[A_NL + tid] = (c > 0) ? NBUF[u * 256 + tid] : 0.f;
        const bf16* qp = PROJ + (size_t)(t0 + 16 * wave + lm) * PROJW + 3072 + h * 256 + 8 * g;
        float qn = 0.f;
        f32x4 acc[16];
#pragma unroll
        for (int j = 0; j < 16; ++j) acc[j] = (f32x4){0.f, 0.f, 0.f, 0.f};
        if (c > 0) {
            const bf16* ct = CT + (size_t)u * 65536;
#pragma unroll 4
            for (int i = 0; i < 16; ++i) { const int q = tid + NTHR * i, e = q >> 5, ch = q & 31;
                const v4u v = *(const GAS v4u*)(ct + (size_t)e * 256 + ch * 8);
                *(LAS v4u*)(lds + (e < 128 ? R0_OFF + e * NRS : R1_OFF + (e - 128) * NRS) + ch * 16) = v; }
            __syncthreads();
            bf16x8 qa = *(const GAS bf16x8*)qp;
#pragma unroll
            for (int kk = 0; kk < 8; ++kk) {
                const bf16x8 qnx = *(const GAS bf16x8*)(qp + 32 * (kk < 7 ? kk + 1 : 7));
#pragma unroll
                for (int j = 0; j < 16; ++j) { const bf16x8 bfr = *(const LAS bf16x8*)(lds + (j < 8 ? R0_OFF : R1_OFF) + (16 * (j & 7) + lm) * NRS + (32 * kk + 8 * g) * 2);
                    acc[j] = __builtin_amdgcn_mfma_f32_16x16x32_bf16(qa, bfr, acc[j], 0, 0, 0); }
#pragma unroll
                for (int jj = 0; jj < 8; ++jj) qn += __uint_as_float(((unsigned)(unsigned short)qa[jj]) << 16) * arr[A_NL + 32 * kk + 8 * g + jj];
                asm volatile("" ::: "memory");
                qa = qnx;
            }
        } else { __syncthreads(); }
        float at[4];
#pragma unroll
        for (int r = 0; r < 4; ++r) { const int t = 16 * wave + 4 * g + r; at[r] = expf(arr[A_BS + t] + mprev - arr[A_MT + t]); }
        qn += __shfl_xor(qn, 16); qn += __shfl_xor(qn, 32);
#pragma unroll
        for (int j = 0; j < 16; ++j)
#pragma unroll
            for (int r = 0; r < 4; ++r) acc[j][r] *= at[r];
        __syncthreads();
        {
#pragma unroll
            for (int i = 0; i < 8; ++i) { const int q = tid + NTHR * i, s = q >> 5, ch = q & 31;
                const v4u v = *(const GAS v4u*)(PROJ + (size_t)(t0 + s) * PROJW + 4096 + h * 256 + ch * 8);
                *(LAS v4u*)(lds + R0_OFF + s * NRS + ch * 16) = v; }
#pragma unroll
            for (int it = 0; it < 4; ++it) {
                const int d0 = (wave * 4 + it) * 8;
                const bf16* r0p = PROJ + (size_t)(t0 + 2 * lane) * PROJW + 5120 + h * 256 + d0;
                const v4u v0 = *(const GAS v4u*)r0p, v1 = *(const GAS v4u*)(r0p + PROJW);
#pragma unroll
                for (int j = 0; j < 4; ++j) {
                    const unsigned va = v0[j], vb = v1[j];
                    *(LAS unsigned*)(lds + R1_OFF + (d0 + 2 * j) * TRS + 4 * lane) = (va & 0xffffu) | (vb << 16);
                    *(LAS unsigned*)(lds + R1_OFF + (d0 + 2 * j + 1) * TRS + 4 * lane) = (va >> 16) | (vb & 0xffff0000u);
                }
            }
        }
        __syncthreads();
        f32x4 sacc[8];
#pragma unroll
        for (int j = 0; j < 8; ++j) sacc[j] = (f32x4){0.f, 0.f, 0.f, 0.f};
        {
            bf16x8 qa = *(const GAS bf16x8*)qp;
#pragma unroll
            for (int kk = 0; kk < 8; ++kk) {
                const bf16x8 qnx = *(const GAS bf16x8*)(qp + 32 * (kk < 7 ? kk + 1 : 7));
#pragma unroll
                for (int j = 0; j < 8; ++j) { const bf16x8 bfr = *(const LAS bf16x8*)(lds + R0_OFF + (16 * j + lm) * NRS + (32 * kk + 8 * g) * 2);
                    sacc[j] = __builtin_amdgcn_mfma_f32_16x16x32_bf16(qa, bfr, sacc[j], 0, 0, 0); }
                asm volatile("" ::: "memory");
                qa = qnx;
            }
        }
        float rb[4], mtr[4], dsum[4];
#pragma unroll
        for (int r = 0; r < 4; ++r) { const int t = 16 * wave + 4 * g + r; mtr[r] = arr[A_MT + t]; rb[r] = arr[A_BS + t] - mtr[r]; dsum[r] = 0.f; }
#pragma unroll
        for (int j = 0; j < 8; ++j) { const int s = 16 * j + lm; const float cb = arr[A_IS + s] - arr[A_BS + s];
#pragma unroll
            for (int r = 0; r < 4; ++r) { const int t = 16 * wave + 4 * g + r; const float p = (s <= t) ? sacc[j][r] * 0.0625f * __expf(rb[r] + cb) : 0.f; sacc[j][r] = p; dsum[r] += p; } }
#pragma unroll
        for (int r = 0; r < 4; ++r) { float d = dsum[r]; d += __shfl_xor(d, 1); d += __shfl_xor(d, 2); d += __shfl_xor(d, 4); d += __shfl_xor(d, 8); dsum[r] = d; }
        __syncthreads();
#pragma unroll
        for (int j = 0; j < 8; ++j)
#pragma unroll
            for (int r = 0; r < 4; ++r) *(LAS unsigned short*)(lds + R0_OFF + (16 * wave + 4 * g + r) * TRS + (16 * j + lm) * 2) = (unsigned short)f2bf(sacc[j][r]);
        __syncthreads();
#pragma unroll
        for (int kk = 0; kk < 4; ++kk) {
            const bf16x8 pa = *(const LAS bf16x8*)(lds + R0_OFF + (16 * wave + lm) * TRS + (32 * kk + 8 * g) * 2);
#pragma unroll
            for (int j = 0; j < 16; ++j) { const bf16x8 vb = *(const LAS bf16x8*)(lds + R1_OFF + (16 * j + lm) * TRS + (32 * kk + 8 * g) * 2);
                acc[j] = __builtin_amdgcn_mfma_f32_16x16x32_bf16(pa, vb, acc[j], 0, 0, 0); }
            asm volatile("" ::: "memory");
        }
        float ssq[4], inv[4];
#pragma unroll
        for (int r = 0; r < 4; ++r) { const float qnr = __shfl(qn, 4 * g + r); const float den = at[r] * qnr + dsum[r]; inv[r] = 1.0f / fmaxf(fabsf(den), expf(-mtr[r])); ssq[r] = 0.f; }
#pragma unroll
        for (int j = 0; j < 16; ++j)
#pragma unroll
            for (int r = 0; r < 4; ++r) { const float hv = acc[j][r] * inv[r]; acc[j][r] = hv; ssq[r] += hv * hv; }
#pragma unroll
        for (int r = 0; r < 4; ++r) { float d = ssq[r]; d += __shfl_xor(d, 1); d += __shfl_xor(d, 2); d += __shfl_xor(d, 4); d += __shfl_xor(d, 8); ssq[r] = 1.0f / sqrtf(d * (1.0f / 256.0f) + EPS); }
#pragma unroll
        for (int j = 0; j < 16; ++j) { const int e = 16 * j + lm; const float gmv = gm[h * 256 + e];
#pragma unroll
            for (int r = 0; r < 4; ++r) { const size_t tg = (size_t)(t0 + 16 * wave + 4 * g + r);
                const float o = __uint_as_float(((unsigned)PROJ[tg * PROJW + 6144 + h * 256 + e]) << 16);
                const float yv = (acc[j][r] * ssq[r] * gmv) / (1.0f + __expf(-o));
                Y[tg * DM + 1024 + h * 256 + e] = (bf16)f2bf(yv); }
            asm volatile("" ::: "memory"); }
    }
}

__device__ __forceinline__ unsigned fkey(float v) { const unsigned u = __float_as_uint(v); return (u & 0x80000000u) ? ~u : (u | 0x80000000u); }
__device__ __forceinline__ float fdec(unsigned k) { return __uint_as_float((k & 0x80000000u) ? (k & 0x7fffffffu) : ~k); }
#define TK_INSERT(list, key) do { unsigned _k = (key); _Pragma("unroll") for (int _j = 0; _j < 16; ++_j) { const unsigned _hi = max(list[_j], _k); _k = min(list[_j], _k); list[_j] = _hi; } } while (0)

__device__ __forceinline__ void phase5(const Args& A, LAS unsigned char* lds, int tid, int lane, int wave) {
    unsigned char* ws = A.ws;
    const bf16* QP = (const bf16*)(ws + WS_Y); const bf16* KEYS = (const bf16*)(ws + WS_KEYS);
    int* IDX = (int*)(ws + WS_IDX); float* GW = (float*)(ws + WS_GW);
    LAS float* SC = (LAS float*)lds;
    LAS unsigned* LST = (LAS unsigned*)lds;
    const int lm = lane & 15, g = lane >> 4;
    for (int u = blockIdx.x; u < 512; u += gridDim.x) {
        const int tt = u >> 3, h = u & 7;
        __syncthreads();
#pragma unroll 1
        for (int p = 0; p < 2; ++p) {
            f32x4 sacc[8];
#pragma unroll
            for (int j = 0; j < 8; ++j) sacc[j] = (f32x4){0.f, 0.f, 0.f, 0.f};
            const bf16* qp = QP + (size_t)(tt * 128 + 16 * wave + lm) * DM + h * 256 + p * 128 + 8 * g;
            const bf16* kp = KEYS + (size_t)((h * 2 + p) * 128 + lm) * 128 + 8 * g;
#pragma unroll
            for (int kk = 0; kk < 4; ++kk) { const bf16x8 af = *(const GAS bf16x8*)(qp + 32 * kk);
#pragma unroll
                for (int j = 0; j < 8; ++j) { const bf16x8 bfr = *(const GAS bf16x8*)(kp + (size_t)(16 * j) * 128 + 32 * kk);
                    sacc[j] = __builtin_amdgcn_mfma_f32_16x16x32_bf16(af, bfr, sacc[j], 0, 0, 0); } }
#pragma unroll
            for (int j = 0; j < 8; ++j)
#pragma unroll
                for (int r = 0; r < 4; ++r) SC[(p * 128 + 16 * wave + 4 * g + r) * 129 + 16 * j + lm] = sacc[j][r];
        }
        __syncthreads();
        unsigned lst[16];
        {
            const int t = (tid >> 1) & 127, half = tid & 1, p = tid >> 8;
            const LAS float* row = SC + (p * 128 + t) * 129;
#pragma unroll
            for (int j = 0; j < 16; ++j) lst[j] = 0u;
#pragma unroll 4
            for (int i = 0; i < 64; ++i) { const int n = 64 * half + ((i + 16 * half) & 63); const unsigned k = (fkey(row[n]) & ~127u) | (unsigned)(127 - n); TK_INSERT(lst, k); }
            unsigned pl[16];
#pragma unroll
            for (int j = 0; j < 16; ++j) pl[j] = __shfl_xor(lst[j], 1);
#pragma unroll
            for (int j = 0; j < 16; ++j) TK_INSERT(lst, pl[j]);
        }
        __syncthreads();
        if ((tid & 1) == 0) { const int t = (tid >> 1) & 127, p = tid >> 8;
#pragma unroll
            for (int j = 0; j < 4; ++j) *(LAS v4u*)(LST + (p * 128 + t) * 16 + 4 * j) = (v4u){lst[4 * j], lst[4 * j + 1], lst[4 * j + 2], lst[4 * j + 3]}; }
        __syncthreads();
        if (tid < 128) {
            const int t = tid;
            float s0[16], s1[16];
#pragma unroll
            for (int j = 0; j < 16; ++j) { s0[j] = fdec(LST[t * 16 + j] & ~127u); s1[j] = fdec(LST[(128 + t) * 16 + j] & ~127u); }
            unsigned cl[16];
#pragma unroll
            for (int j = 0; j < 16; ++j) cl[j] = 0u;
#pragma unroll
            for (int i = 0; i < 16; ++i)
#pragma unroll
                for (int j = 0; j < 16; ++j)
                    if ((i + 1) * (j + 1) <= 16) { const unsigned k = (fkey(s0[i] + s1[j]) & ~255u) | (unsigned)(255 - (i * 16 + j)); TK_INSERT(cl, k); }
            float bs[16]; int ex[16];
#pragma unroll
            for (int k = 0; k < 16; ++k) { const int pos = 255 - (int)(cl[k] & 255u), i = pos >> 4, j = pos & 15;
                const unsigned k0 = LST[t * 16 + i], k1 = LST[(128 + t) * 16 + j];
                bs[k] = fdec(k0 & ~127u) + fdec(k1 & ~127u); ex[k] = (127 - (int)(k0 & 127u)) * 128 + (127 - (int)(k1 & 127u)); }
            float mx = bs[0];
#pragma unroll
            for (int k = 1; k < 16; ++k) mx = fmaxf(mx, bs[k]);
            float sum = 0.f;
#pragma unroll
            for (int k = 0; k < 16; ++k) { bs[k] = expf(bs[k] - mx); sum += bs[k]; }
            const float rs = 1.0f / sum;
            const size_t o = ((size_t)(tt * 128 + t) * 8 + h) * 16;
#pragma unroll
            for (int k = 0; k < 4; ++k) { *(GAS v4u*)(IDX + o + 4 * k) = (v4u){(unsigned)ex[4 * k], (unsigned)ex[4 * k + 1], (unsigned)ex[4 * k + 2], (unsigned)ex[4 * k + 3]};
                *(GAS f32x4*)(GW + o + 4 * k) = (f32x4){bs[4 * k] * rs, bs[4 * k + 1] * rs, bs[4 * k + 2] * rs, bs[4 * k + 3] * rs}; }
        }
    }
}

__device__ __forceinline__ float gelu_erf(float a) { return 0.5f * a * (1.0f + erff(a * 0.70710678118654752f)); }
__device__ __forceinline__ float dot8(const v4u w, const f32x4 xa, const f32x4 xb) {
    return (bflo(w.x) * xa.x + bfhi(w.x) * xa.y) + (bflo(w.y) * xa.z + bfhi(w.y) * xa.w) + (bflo(w.z) * xb.x + bfhi(w.z) * xb.y) + (bflo(w.w) * xb.z + bfhi(w.w) * xb.w);
}
__device__ __forceinline__ void axpy8(f32x4& oa, f32x4& ob, const float wk, const v4u w) {
    oa.x += wk * bflo(w.x); oa.y += wk * bfhi(w.x); oa.z += wk * bflo(w.y); oa.w += wk * bfhi(w.y);
    ob.x += wk * bflo(w.z); ob.y += wk * bfhi(w.z); ob.z += wk * bflo(w.w); ob.w += wk * bfhi(w.w);
}
__device__ __forceinline__ void phase6(const Args& A, int lane, int wave) {
    unsigned char* ws = A.ws;
    const int* IDX = (const int*)(ws + WS_IDX); const float* GW = (const float*)(ws + WS_GW);
    const bf16* U16 = (const bf16*)(ws + WS_U16); const bf16* V16 = (const bf16*)(ws + WS_V16);
    float* H = (float*)(ws + WS_UBUF); const float* PART = (const float*)(ws + WS_PART); bf16* XN3 = (bf16*)(ws + WS_XN);
    const float* gf = A.in[8]; const float* gp = A.in[13];
    const int gw = blockIdx.x * NWAVES + wave, NGW = gridDim.x * NWAVES;
    for (int t = gw; t < NT; t += NGW) {
        const int id0 = IDX[(size_t)t * 128 + lane], id1 = IDX[(size_t)t * 128 + 64 + lane];
        const float g0 = GW[(size_t)t * 128 + lane], g1 = GW[(size_t)t * 128 + 64 + lane];
        f32x4 x[8];
        float ps = PART[(size_t)t * 32 + (lane & 31)];
        ps += __shfl_xor(ps, 1); ps += __shfl_xor(ps, 2); ps += __shfl_xor(ps, 4); ps += __shfl_xor(ps, 8); ps += __shfl_xor(ps, 16);
        const float rstd2 = 1.0f / sqrtf(ps * (1.0f / DM) + EPS);
        { const GAS f32x4* gr = (const GAS f32x4*)gf + 2 * lane; const GAS f32x4* hr = (const GAS f32x4*)(H + (size_t)t * DM) + 2 * lane;
#pragma unroll
          for (int j = 0; j < 4; ++j) { x[2 * j] = hr[128 * j] * rstd2 * gr[128 * j]; x[2 * j + 1] = hr[128 * j + 1] * rstd2 * gr[128 * j + 1]; } }
        float a0 = 0.f, a1 = 0.f;
#pragma unroll 1
        for (int kb = 0; kb < 128; kb += 4) {
            v4u w[4][4];
#pragma unroll
            for (int q = 0; q < 4; ++q) { const int k = kb + q; const int e = __builtin_amdgcn_readlane(k < 64 ? id0 : id1, k & 63);
                const GAS v4u* row = (const GAS v4u*)(U16 + (size_t)e * DM) + lane;
#pragma unroll
                for (int j = 0; j < 4; ++j) w[q][j] = row[64 * j]; }
#pragma unroll
            for (int q = 0; q < 4; ++q) { const int k = kb + q; float p = 0.f;
#pragma unroll
                for (int j = 0; j < 4; ++j) p += dot8(w[q][j], x[2 * j], x[2 * j + 1]);
                p = wave_sum(p);
                if ((k & 63) == lane) { if (k < 64) a0 = p; else a1 = p; } }
        }
        const float w0 = gelu_erf(a0) * g0, w1 = gelu_erf(a1) * g1;
        f32x4 o[8];
#pragma unroll
        for (int j = 0; j < 8; ++j) o[j] = (f32x4){0.f, 0.f, 0.f, 0.f};
#pragma unroll 1
        for (int kb = 0; kb < 128; kb += 4) {
            v4u w[4][4]; float wk[4];
#pragma unroll
            for (int q = 0; q < 4; ++q) { const int k = kb + q; const int e = __builtin_amdgcn_readlane(k < 64 ? id0 : id1, k & 63);
                wk[q] = __int_as_float(__builtin_amdgcn_readlane(__float_as_int(k < 64 ? w0 : w1), k & 63));
                const GAS v4u* row = (const GAS v4u*)(V16 + (size_t)e * DM) + lane;
#pragma unroll
                for (int j = 0; j < 4; ++j) w[q][j] = row[64 * j]; }
#pragma unroll
            for (int q = 0; q < 4; ++q)
#pragma unroll
                for (int j = 0; j < 4; ++j) axpy8(o[2 * j], o[2 * j + 1], wk[q], w[q][j]);
        }
        float ss = 0.f; f32x4 hv[8];
        { const GAS f32x4* hr = (const GAS f32x4*)(H + (size_t)t * DM) + 2 * lane;
#pragma unroll
          for (int j = 0; j < 4; ++j) { hv[2 * j] = hr[128 * j]; hv[2 * j + 1] = hr[128 * j + 1]; } }
#pragma unroll
        for (int j = 0; j < 8; ++j) { hv[j] = hv[j] + o[j]; ss += (hv[j].x * hv[j].x + hv[j].y * hv[j].y) + (hv[j].z * hv[j].z + hv[j].w * hv[j].w); }
        const float rstd3 = 1.0f / sqrtf(wave_sum(ss) * (1.0f / DM) + EPS);
        { GAS f32x4* hr = (GAS f32x4*)(H + (size_t)t * DM) + 2 * lane; const GAS f32x4* gr = (const GAS f32x4*)gp + 2 * lane; GAS v4u* xo = (GAS v4u*)(XN3 + (size_t)t * DM) + lane;
#pragma unroll
          for (int j = 0; j < 4; ++j) { hr[128 * j] = hv[2 * j]; hr[128 * j + 1] = hv[2 * j + 1];
              const f32x4 ya = hv[2 * j] * rstd3 * gr[128 * j], yb = hv[2 * j + 1] * rstd3 * gr[128 * j + 1];
              v4u ov; ov.x = pk2(ya.x, ya.y); ov.y = pk2(ya.z, ya.w); ov.z = pk2(yb.x, yb.y); ov.w = pk2(yb.z, yb.w); xo[64 * j] = ov; } }
    }
}

__device__ __forceinline__ void phase8(const Args& A, int lane, int wave) {
    const float* PART2 = (const float*)(A.ws + WS_PART2); const float* gfin = A.in[16]; float* out = A.out;
    const int gw = blockIdx.x * NWAVES + wave, NGW = gridDim.x * NWAVES;
    for (int t = gw; t < NT; t += NGW) {
        float ps = PART2[(size_t)t * 32 + (lane & 31)];
        ps += __shfl_xor(ps, 1); ps += __shfl_xor(ps, 2); ps += __shfl_xor(ps, 4); ps += __shfl_xor(ps, 8); ps += __shfl_xor(ps, 16);
        const float rstd = 1.0f / sqrtf(ps * (1.0f / DM) + EPS);
        GAS f32x4* r = (GAS f32x4*)(out + (size_t)t * DM) + lane; const GAS f32x4* gr = (const GAS f32x4*)gfin + lane;
#pragma unroll
        for (int j = 0; j < 8; ++j) r[64 * j] = r[64 * j] * rstd * gr[64 * j];
    }
}

__global__ void __launch_bounds__(NTHR, 2) mk_fwd(Args args) {
    extern __shared__ __attribute__((aligned(16))) unsigned char lds_raw[];
    LAS unsigned char* lds = (LAS unsigned char*)lds_raw;
    int tid = threadIdx.x, lane = tid & 63, wave = __builtin_amdgcn_readfirstlane(tid >> 6);
#define FRESH_TID() do { tid = threadIdx.x; asm volatile("" : "+v"(tid)); lane = tid & 63; wave = __builtin_amdgcn_readfirstlane(tid >> 6); } while (0)
    volatile LAS unsigned* MISC = (volatile LAS unsigned*)(lds + MISC_OFF);
    if (tid < 32) MISC[tid] = 0u;
    __syncthreads();
    unsigned char* ws = args.ws;
    XcdBarrier bar = xcd_barrier_post((unsigned*)(ws + WS_CTL) + CW_BAR, MISC + 8);
    const int G = gridDim.x, bx = blockIdx.x;

#ifndef NO_P0
    FRESH_TID(); phase0(args, lds, tid, lane, wave);
#endif
    xcd_barrier(bar);
    {
        pg8::Gemm g{(const bf16*)(ws + WS_XN), (const bf16*)(ws + WS_WIN), NT, PROJW, DM}; pg8::StaticOrder S; S.init(NT, PROJW, G, bx);
        pg8::EpiBf16<0> E{(bf16*)(ws + WS_PROJ), PROJW, nullptr, 0, 0, 1.f};
        pg8::gemm_phase<pg8::EpiBf16<0>, pg8::StaticOrder, true, true>(lds, g, S, E);
        pg8::Gemm g2{(const bf16*)(ws + WS_P16), (const bf16*)(ws + WS_WP), NT, DM, 256}; pg8::StaticOrder S2; S2.init(NT, DM, G, bx);
        pg8::EpiBf16<0> E2{(bf16*)(ws + WS_PP), DM, nullptr, 0, 0, 1.f};
        pg8::gemm_phase<pg8::EpiBf16<0>, pg8::StaticOrder, true, true>(lds, g2, S2, E2);
    }
    xcd_barrier(bar);
#ifndef NO_X1
    FRESH_TID(); phase_x1(args, lds, tid, lane, wave);
#endif
    xcd_barrier(bar);
#ifndef NO_X2
    FRESH_TID(); phase_x2(args, tid);
#endif
    xcd_barrier(bar);
#ifndef NO_X3
    FRESH_TID(); phase_x3(args, lds, tid, lane, wave);
#endif
    xcd_barrier(bar);
    {
        pg8::Gemm g{(const bf16*)(ws + WS_Y), (const bf16*)(ws + WS_WOUT), NT, DM, DM}; pg8::StaticOrder S; S.init(NT, DM, G, bx);
        pg8::EpiResidual E{args.in[0], (float*)(ws + WS_UBUF), (bf16*)(ws + WS_XN), (float*)(ws + WS_PART), DM};
        pg8::gemm_phase<pg8::EpiResidual, pg8::StaticOrder, true, true>(lds, g, S, E);
    }
    xcd_barrier(bar);
    {
        pg8::Gemm g{(const bf16*)(ws + WS_XN), (const bf16*)(ws + WS_WQ), NT, DM, DM}; pg8::StaticOrder S; S.init(NT, DM, G, bx);
        LAS float* rs = (LAS float*)(lds + RS_OFF);
        pg8::Unit u0; FRESH_TID();
        if (S.next(0, u0)) {
            const float* PART = (const float*)(ws + WS_PART);
            const int row = tid >> 1, hf = tid & 1; const float* pr = PART + (size_t)(u0.pm * 256 + row) * 32 + hf * 16; float s = 0.f;
#pragma unroll
            for (int i = 0; i < 4; ++i) { const f32x4 v = *(const GAS f32x4*)(pr + 4 * i); s += (v.x + v.y) + (v.z + v.w); }
            s += __shfl_xor(s, 1);
            if (hf == 0) rs[row] = 1.0f / sqrtf(s * (1.0f / DM) + EPS);
        }
        __syncthreads();
        pg8::EpiRowScaleBf16 E{(bf16*)(ws + WS_Y), DM, (const PG8_LAS float*)rs};
        pg8::gemm_phase<pg8::EpiRowScaleBf16, pg8::StaticOrder, true, true>(lds, g, S, E);
    }
    xcd_barrier(bar);
#ifndef NO_P5
    FRESH_TID(); phase5(args, lds, tid, lane, wave);
#endif
    xcd_barrier(bar);
#ifndef NO_P6
    FRESH_TID(); phase6(args, lane, wave);
#endif
    xcd_barrier(bar);
    {
        pg8::Gemm g{(const bf16*)(ws + WS_XN), (const bf16*)(ws + WS_WG), NT, DM, DM}; pg8::StaticOrder S; S.init(NT, DM, G, bx);
        pg8::EpiGate E{(const float*)(ws + WS_UBUF), (const bf16*)(ws + WS_PP), args.out, (float*)(ws + WS_PART2), DM};
        pg8::gemm_phase<pg8::EpiGate, pg8::StaticOrder, true, true>(lds, g, S, E);
    }
    xcd_barrier(bar);
#ifndef NO_P8
    FRESH_TID(); phase8(args, lane, wave);
#endif
}

extern "C" void kernel_launch(void* const* d_in, const int* in_sizes, int n_in, void* d_out, int out_size, void* d_ws, size_t ws_size, hipStream_t stream) {
    static int grid = 0;
    if (grid == 0) {
        if (n_in != 17 || out_size != NT * DM || ws_size < WS_END) { fprintf(stderr, "kernel_launch: unexpected shapes (n_in %d, out %d, ws %zu); nothing launched\n", n_in, out_size, ws_size); grid = -1; return; }
        int dev = 0, cus = 0, per_cu = 0;
        if (hipGetDevice(&dev) != hipSuccess || hipDeviceGetAttribute(&cus, hipDeviceAttributeMultiprocessorCount, dev) != hipSuccess) { grid = -1; return; }
        if (hipFuncSetAttribute((const void*)mk_fwd, hipFuncAttributeMaxDynamicSharedMemorySize, LDS_BYTES) != hipSuccess) { fprintf(stderr, "kernel_launch: hipFuncSetAttribute failed\n"); grid = -1; return; }
        if (hipOccupancyMaxActiveBlocksPerMultiprocessor(&per_cu, (const void*)mk_fwd, NTHR, LDS_BYTES) != hipSuccess || per_cu < 1) { fprintf(stderr, "kernel_launch: occupancy query says %d blocks per CU\n", per_cu); }
        (void)hipGetLastError();
        grid = cus;
    }
    if (grid < 0) return;
    (void)hipMemsetAsync((char*)d_ws + WS_CTL, 0, CTL_ZERO_BYTES, stream);
    Args a{};
    for (int i = 0; i < 17; ++i) a.in[i] = (const float*)d_in[i];
    a.out = (float*)d_out; a.ws = (unsigned char*)d_ws; a.pad = 0ull;
    hipLaunchKernelGGL(mk_fwd, dim3(grid), dim3(NTHR), LDS_BYTES, stream, a);
}
```

```cpp
#include <hip/hip_runtime.h>
#include <cstdio>
#include <cstdint>
#include <cmath>
namespace pg8 {
#define PG8_LAS __attribute__((address_space(3)))
typedef unsigned short bf16_t;
typedef short bf16x8 __attribute__((ext_vector_type(8)));
typedef float f32x4 __attribute__((ext_vector_type(4)));
typedef unsigned u32x4 __attribute__((ext_vector_type(4)));
constexpr int BM = 256, BK = 64, HALF = 128, HTB = HALF * BK * 2  , STAGE_BYTES = 8 * HTB, NXCD = 8, WGM = 8;

__host__ __device__ __forceinline__ int lds_byte(int r, int c) { const int st = (r >> 4) * 2 + (c >> 5), rr = r & 15, cc = c & 31, ob = rr * 64 + cc * 2; return st * 1024 + (ob ^ (((ob >> 9) & 1) << 5)); }
__host__ __device__ __forceinline__ void stage_rc(int b, int& R, int& C) { const int st = b / 1024, sb = b % 1024, swz = sb ^ (((sb >> 9) & 1) << 5); R = (st >> 1) * 16 + swz / 64; C = (st & 1) * 32 + (swz % 64) / 2; }
__host__ __device__ __forceinline__ int perm32(int rho) { const int n = rho >> 4, i = rho & 15; return 8 * (i >> 2) + 4 * n + (i & 3); }

struct Unit { int pm, pn; };
struct Gemm { const bf16_t* A; const bf16_t* Bt; int M, N, K; };

struct StaticOrder {
    int nM, nN, nwg, G, c;
    __host__ __device__ void init(int M, int N, int G_, int c_) { nM = M / BM; nN = N / BM; nwg = nM * nN; G = G_; c = c_; }
    __host__ __device__ bool next(int i, Unit& u) const {
        const long L = (long)i * G + c; if (L >= nwg) return false;
        int wgid = (int)L; { const int q = nwg / NXCD, r = nwg % NXCD, xcd = wgid % NXCD, off = wgid / NXCD; wgid = (xcd < r ? xcd * (q + 1) : r * (q + 1) + (xcd - r) * q) + off; }
        const int nig = WGM * nN, gid = wgid / nig, fm = gid * WGM, gsz = (nM - fm) < WGM ? (nM - fm) : WGM;
        u.pm = fm + ((wgid % nig) % gsz); u.pn = (wgid % nig) / gsz; return true;
    }
    __device__ __forceinline__ void a_ready(const Unit&) const {}
    __device__ __forceinline__ void done(const Unit&) const {}
};

__device__ __forceinline__ unsigned cvt_pk_bf16(float lo, float hi) { unsigned r; asm volatile("v_cvt_pk_bf16_f32 %0, %1, %2" : "=v"(r) : "v"(lo), "v"(hi)); return r; }
typedef float f32x2 __attribute__((ext_vector_type(2)));
__device__ __forceinline__ f32x2 gelu_pk(f32x2 v) {
    const f32x2 av = __builtin_elementwise_abs(v), d = av * 0.2316418882f + 1.0f;
    f32x2 t; t.x = __builtin_amdgcn_rcpf(d.x); t.y = __builtin_amdgcn_rcpf(d.y);
    f32x2 q = t * 0.5307027145f + (-0.7265760135f); q = q * t + 0.7107068705f; q = q * t + (-0.142248368f); q = q * t + 0.127414796f; q = q * t;
    const f32x2 s = (v * v) * (-0.72134752044f);
    f32x2 e; e.x = __builtin_amdgcn_exp2f(s.x); e.y = __builtin_amdgcn_exp2f(s.y);
    const f32x2 m = v * (q * e), r = v - m;
    f32x2 o; o.x = v.x < 0.f ? m.x : r.x; o.y = v.y < 0.f ? m.y : r.y; return o;
}

template <int ACT  > struct EpiBf16 {
    static constexpr bool PERM = true, AFTER_DRAIN = false; static_assert(ACT == 0 || ACT == 1, "EpiBf16: ACT is 0 (none) or 1 (gelu_pk)");
    bf16_t* O; int ldc; const float* bias; int split_cols; size_t split_stride; float scale0;
    __device__ __forceinline__ void operator()(const f32x4 (&acc)[2][2][4][2], const Unit& u, int wr, int wc, int fr, int fq) const {
        const int row0 = u.pm * BM + wr * 64 + fr; int colt = u.pn * BM; bf16_t* base = O;
        float sc = 1.f; if (split_cols) { const int t = colt / split_cols; base += (size_t)t * split_stride; colt -= t * split_cols; if (t == 0) sc = scale0; }
        const int col0 = colt + wc * 32 + 8 * fq, bcol0 = u.pn * BM + wc * 32 + 8 * fq;
        f32x4 bv[2][2];
#pragma unroll
        for (int bj = 0; bj < 2; ++bj)
#pragma unroll
            for (int n = 0; n < 2; ++n) bv[bj][n] = bias ? *(const f32x4*)(bias + bcol0 + bj * HALF + 4 * n) : (f32x4){0.f, 0.f, 0.f, 0.f};
#pragma unroll
        for (int ai = 0; ai < 2; ++ai)
#pragma unroll
            for (int m = 0; m < 4; ++m) { bf16_t* rowp = base + (size_t)(row0 + ai * HALF + m * 16) * ldc + col0;
#pragma unroll
                for (int bj = 0; bj < 2; ++bj) { f32x4 v0 = acc[ai][bj][m][0] + bv[bj][0], v1 = acc[ai][bj][m][1] + bv[bj][1];
                    if (ACT == 1) { f32x2 a = gelu_pk((f32x2){v0[0], v0[1]}), b = gelu_pk((f32x2){v0[2], v0[3]}), c = gelu_pk((f32x2){v1[0], v1[1]}), d = gelu_pk((f32x2){v1[2], v1[3]});
                        v0 = (f32x4){a.x, a.y, b.x, b.y}; v1 = (f32x4){c.x, c.y, d.x, d.y}; }
                    v0 = v0 * sc; v1 = v1 * sc; u32x4 w; w.x = cvt_pk_bf16(v0[0], v0[1]); w.y = cvt_pk_bf16(v0[2], v0[3]); w.z = cvt_pk_bf16(v1[0], v1[1]); w.w = cvt_pk_bf16(v1[2], v1[3]);
                    *(u32x4*)(rowp + bj * HALF) = w; } }
    }
};

typedef unsigned u32x2 __attribute__((ext_vector_type(2)));
struct EpiRowScaleBf16 {
    static constexpr bool PERM = true, AFTER_DRAIN = false;
    bf16_t* O; int ldc; const PG8_LAS float* rs;
    __device__ __forceinline__ void operator()(const f32x4 (&acc)[2][2][4][2], const Unit& u, int wr, int wc, int fr, int fq) const {
        const int col0 = u.pn * BM + wc * 32 + 8 * fq;
#pragma unroll
        for (int ai = 0; ai < 2; ++ai)
#pragma unroll
            for (int m = 0; m < 4; ++m) { const int rl = ai * HALF + wr * 64 + m * 16 + fr; const float s = rs[rl]; bf16_t* rowp = O + (size_t)(u.pm * BM + rl) * ldc + col0;
#pragma unroll
                for (int bj = 0; bj < 2; ++bj) { const f32x4 v0 = acc[ai][bj][m][0] * s, v1 = acc[ai][bj][m][1] * s;
                    u32x4 w; w.x = cvt_pk_bf16(v0[0], v0[1]); w.y = cvt_pk_bf16(v0[2], v0[3]); w.z = cvt_pk_bf16(v1[0], v1[1]); w.w = cvt_pk_bf16(v1[2], v1[3]);
                    *(u32x4*)(rowp + bj * HALF) = w; } }
    }
};
struct EpiResidual {
    static constexpr bool PERM = false, AFTER_DRAIN = false;
    const float* X; float* H; bf16_t* Hb; float* part; int ldc;
    __device__ __forceinline__ void operator()(const f32x4 (&acc)[2][2][4][2], const Unit& u, int wr, int wc, int fr, int fq) const {
        const int col0 = u.pn * BM + wc * 32 + 4 * fq;
#pragma unroll
        for (int ai = 0; ai < 2; ++ai)
#pragma unroll
            for (int m = 0; m < 4; ++m) { const int r = u.pm * BM + ai * HALF + wr * 64 + m * 16 + fr; const size_t off = (size_t)r * ldc + col0; float ss = 0.f;
#pragma unroll
                for (int bj = 0; bj < 2; ++bj)
#pragma unroll
                    for (int n = 0; n < 2; ++n) { const size_t o = off + bj * HALF + n * 16; const f32x4 v = acc[ai][bj][m][n] + *(const f32x4*)(X + o);
                        *(f32x4*)(H + o) = v; u32x2 w; w.x = cvt_pk_bf16(v[0], v[1]); w.y = cvt_pk_bf16(v[2], v[3]); *(u32x2*)(Hb + o) = w;
                        ss += (v[0] * v[0] + v[1] * v[1]) + (v[2] * v[2] + v[3] * v[3]); }
                ss += __shfl_xor(ss, 16); ss += __shfl_xor(ss, 32);
                if (fq == 0) part[(size_t)r * 32 + u.pn * 4 + wc] = ss; }
    }
};
struct EpiGate {
    static constexpr bool PERM = false, AFTER_DRAIN = false;
    const float* H2; const bf16_t* PP; float* OUT; float* part; int ldc;
    __device__ __forceinline__ void operator()(const f32x4 (&acc)[2][2][4][2], const Unit& u, int wr, int wc, int fr, int fq) const {
        const int col0 = u.pn * BM + wc * 32 + 4 * fq;
#pragma unroll
        for (int ai = 0; ai < 2; ++ai)
#pragma unroll
            for (int m = 0; m < 4; ++m) { const int r = u.pm * BM + ai * HALF + wr * 64 + m * 16 + fr; const size_t off = (size_t)r * ldc + col0; float ss = 0.f;
#pragma unroll
                for (int bj = 0; bj < 2; ++bj)
#pragma unroll
                    for (int n = 0; n < 2; ++n) { const size_t o = off + bj * HALF + n * 16; const f32x4 a = acc[ai][bj][m][n]; const f32x4 hv = *(const f32x4*)(H2 + o); const u32x2 pw = *(const u32x2*)(PP + o);
                        f32x4 pp; pp[0] = __uint_as_float(pw.x << 16); pp[1] = __uint_as_float(pw.x & 0xffff0000u); pp[2] = __uint_as_float(pw.y << 16); pp[3] = __uint_as_float(pw.y & 0xffff0000u);
                        f32x4 v;
#pragma unroll
                        for (int i = 0; i < 4; ++i) v[i] = hv[i] + pp[i] / (1.0f + __expf(-a[i]));
                        *(f32x4*)(OUT + o) = v;
                        ss += (v[0] * v[0] + v[1] * v[1]) + (v[2] * v[2] + v[3] * v[3]); }
                ss += __shfl_xor(ss, 16); ss += __shfl_xor(ss, 32);
                if (fq == 0) part[(size_t)r * 32 + u.pn * 4 + wc] = ss; }
    }
};
template <class Epi, class Sched, bool ALIGN_EPI = false, bool SP2 = false>
__device__ __forceinline__ void gemm_phase(PG8_LAS unsigned char* lds, const Gemm g, const Sched& S, const Epi& E) {
    int tid_o = threadIdx.x; asm volatile("" : "+v"(tid_o));
    const int tid = tid_o, wid = __builtin_amdgcn_readfirstlane(tid >> 6), lane = tid & 63, wr = wid >> 2, wc = wid & 3, fr = lane & 15, fq = lane >> 4;
    const int K = g.K, nt = K / BK;
    unsigned voffA[2], voffB[2];
#pragma unroll
    for (int i = 0; i < 2; ++i) { int R, C; stage_rc(tid * 16 + i * 8192, R, C); const int Rb = Epi::PERM ? ((R & ~31) + perm32(R & 31)) : R;
        voffA[i] = (unsigned)(R * K + C) * 2u; voffB[i] = (unsigned)(Rb * K + C) * 2u; }
    const size_t kstep = (size_t)(BK * 2);
    const size_t hstep = (size_t)HALF * K * 2;
    const size_t tstep = 2 * hstep;
    const unsigned ldsw = (unsigned)wid * 1024u;
    const int aoff = lds_byte(wr * 64 + fr, fq * 8), boff = lds_byte(wc * 32 + fr, fq * 8);
#define PG8_SA(b, h) (((b) * 2 + (h)) * HTB)
#define PG8_SB(b, h) ((4 + (b) * 2 + (h)) * HTB)
#define PG8_STAGE(bufoff, gbase, voff) do { _Pragma("unroll") for (int _i = 0; _i < 2; ++_i) \
        __builtin_amdgcn_global_load_lds((const unsigned*)((const char*)(gbase) + (voff)[_i]), (PG8_LAS unsigned*)(lds + (bufoff) + ldsw + _i * 8192), 16, 0, 0); } while (0)
#define PG8_LDA(dst, b, h) do { _Pragma("unroll") for (int m = 0; m < 4; ++m) _Pragma("unroll") for (int k = 0; k < 2; ++k) dst[m][k] = *(const PG8_LAS bf16x8*)(lds + PG8_SA(b, h) + aoff + m * 2048 + k * 1024); } while (0)
#define PG8_LDB(dst, b, h) do { _Pragma("unroll") for (int n = 0; n < 2; ++n) _Pragma("unroll") for (int k = 0; k < 2; ++k) dst[n][k] = *(const PG8_LAS bf16x8*)(lds + PG8_SB(b, h) + boff + n * 2048 + k * 1024); } while (0)
#define PG8_MMA(ai, bj, At, Bt) do { __builtin_amdgcn_s_setprio(1); _Pragma("unroll") for (int m = 0; m < 4; ++m) _Pragma("unroll") for (int n = 0; n < 2; ++n) _Pragma("unroll") for (int k = 0; k < 2; ++k) \
        acc[ai][bj][m][n] = __builtin_amdgcn_mfma_f32_16x16x32_bf16(Bt[n][k], At[m][k], acc[ai][bj][m][n], 0, 0, 0); __builtin_amdgcn_s_setprio(0); } while (0)
#define PG8_WAIT_V(n) asm volatile("s_waitcnt vmcnt(" #n ")" ::: "memory")
#define PG8_WAIT_L(n) asm volatile("s_waitcnt lgkmcnt(" #n ")" ::: "memory")
#define PG8_BAR __builtin_amdgcn_s_barrier()
#define PG8_SCHED __builtin_amdgcn_sched_barrier(0)
    Unit cur, nxt; int ui = 0;
    if (!S.next(0, cur)) return;
    f32x4 acc[2][2][4][2];
#pragma unroll
    for (int a = 0; a < 2; ++a)
#pragma unroll
        for (int b = 0; b < 2; ++b)
#pragma unroll
            for (int m = 0; m < 4; ++m)
#pragma unroll
                for (int n = 0; n < 2; ++n) acc[a][b][m][n] = (f32x4){0.f, 0.f, 0.f, 0.f};
    bf16x8 At[4][2], B0[2][2], B1[2][2];
    const char* cA = (const char*)g.A + (size_t)cur.pm * tstep; const char* cB = (const char*)g.Bt + (size_t)cur.pn * tstep;
    S.a_ready(cur);
    if constexpr (SP2) {
        PG8_STAGE(PG8_SB(0, 0), cB, voffB); PG8_STAGE(PG8_SB(0, 1), cB + hstep, voffB); PG8_STAGE(PG8_SA(0, 0), cA, voffA); PG8_STAGE(PG8_SA(0, 1), cA + hstep, voffA);
        if (wr == 1) PG8_BAR;
        PG8_WAIT_V(2); PG8_BAR;
        PG8_STAGE(PG8_SB(1, 0), cB + kstep, voffB); PG8_STAGE(PG8_SA(1, 0), cA + kstep, voffA); PG8_STAGE(PG8_SB(1, 1), cB + hstep + kstep, voffB);
        PG8_WAIT_V(6); PG8_BAR;
    } else {
        PG8_STAGE(PG8_SB(0, 0), cB, voffB); PG8_STAGE(PG8_SA(0, 0), cA, voffA); PG8_STAGE(PG8_SB(0, 1), cB + hstep, voffB); PG8_STAGE(PG8_SA(0, 1), cA + hstep, voffA);
        if (wr == 1) PG8_BAR;
        PG8_WAIT_V(4); PG8_BAR;
        PG8_STAGE(PG8_SB(1, 0), cB + kstep, voffB); PG8_STAGE(PG8_SA(1, 0), cA + kstep, voffA); PG8_STAGE(PG8_SB(1, 1), cB + hstep + kstep, voffB);
        PG8_WAIT_V(6); PG8_BAR;
    }
    for (;;) {
        const bool has_next = S.next(ui + 1, nxt);
        const char* nA = has_next ? (const char*)g.A + (size_t)nxt.pm * tstep : cA; const char* nB = has_next ? (const char*)g.Bt + (size_t)nxt.pn * tstep : cB;
        for (int t = 0; t < nt; t += 2) {
            const bool last = (t == nt - 2);
            const char* a1 = cA + (size_t)(t + 1) * kstep;
            const char* a2 = last ? nA : cA + (size_t)(t + 2) * kstep; const char* b2 = last ? nB : cB + (size_t)(t + 2) * kstep;
            const char* a3 = a2 + kstep; const char* b3 = b2 + kstep;
            if (last && has_next) S.a_ready(nxt);
            if constexpr (SP2) {
            PG8_LDB(B0, 0, 0); PG8_LDB(B1, 0, 1); PG8_SCHED; PG8_LDA(At, 0, 0); PG8_STAGE(PG8_SA(1, 1), a1 + hstep, voffA);
            PG8_WAIT_V(8); PG8_WAIT_L(0); PG8_BAR; PG8_MMA(0, 0, At, B0); PG8_MMA(0, 1, At, B1); PG8_BAR; PG8_SCHED;
            PG8_LDA(At, 0, 1); PG8_STAGE(PG8_SB(0, 0), b2, voffB); PG8_STAGE(PG8_SB(0, 1), b2 + hstep, voffB); PG8_STAGE(PG8_SA(0, 0), a2, voffA);
            PG8_WAIT_V(8); PG8_WAIT_L(0); PG8_BAR; PG8_MMA(1, 0, At, B0); PG8_MMA(1, 1, At, B1); PG8_BAR; PG8_SCHED;
            PG8_LDB(B0, 1, 0); PG8_LDB(B1, 1, 1); PG8_SCHED; PG8_LDA(At, 1, 0); PG8_STAGE(PG8_SA(0, 1), a2 + hstep, voffA);
            PG8_WAIT_V(8); PG8_WAIT_L(0); PG8_BAR; PG8_MMA(0, 0, At, B0); PG8_MMA(0, 1, At, B1); PG8_BAR; PG8_SCHED;
            PG8_LDA(At, 1, 1); PG8_STAGE(PG8_SB(1, 0), b3, voffB); PG8_STAGE(PG8_SB(1, 1), b3 + hstep, voffB); PG8_STAGE(PG8_SA(1, 0), a3, voffA);
            PG8_WAIT_V(8); PG8_WAIT_L(0); PG8_BAR; PG8_MMA(1, 0, At, B0); PG8_MMA(1, 1, At, B1); PG8_BAR; PG8_SCHED;
            } else {
            PG8_LDB(B0, 0, 0); PG8_SCHED; PG8_LDA(At, 0, 0); PG8_STAGE(PG8_SA(1, 1), a1 + hstep, voffA);
            PG8_WAIT_L(8); PG8_BAR; PG8_WAIT_L(0); PG8_MMA(0, 0, At, B0); PG8_BAR; PG8_SCHED;
            PG8_LDB(B1, 0, 1); PG8_STAGE(PG8_SB(0, 0), b2, voffB);
            PG8_BAR; PG8_WAIT_L(0); PG8_MMA(0, 1, At, B1); PG8_BAR;
            PG8_LDA(At, 0, 1); PG8_STAGE(PG8_SA(0, 0), a2, voffA);
            PG8_BAR; PG8_WAIT_L(0); PG8_MMA(1, 0, At, B0); PG8_BAR; PG8_SCHED;
            PG8_STAGE(PG8_SB(0, 1), b2 + hstep, voffB);
            PG8_WAIT_V(6); PG8_BAR; PG8_MMA(1, 1, At, B1); PG8_BAR;
            PG8_LDB(B0, 1, 0); PG8_SCHED; PG8_LDA(At, 1, 0); PG8_STAGE(PG8_SA(0, 1), a2 + hstep, voffA);
            PG8_WAIT_L(8); PG8_BAR; PG8_WAIT_L(0); PG8_MMA(0, 0, At, B0); PG8_BAR; PG8_SCHED;
            PG8_LDB(B1, 1, 1); PG8_STAGE(PG8_SB(1, 0), b3, voffB);
            PG8_BAR; PG8_WAIT_L(0); PG8_MMA(0, 1, At, B1); PG8_BAR;
            PG8_LDA(At, 1, 1); PG8_STAGE(PG8_SA(1, 0), a3, voffA);
            PG8_BAR; PG8_WAIT_L(0); PG8_MMA(1, 0, At, B0); PG8_BAR; PG8_SCHED;
            PG8_STAGE(PG8_SB(1, 1), b3 + hstep, voffB);
            PG8_WAIT_V(6); PG8_BAR; PG8_MMA(1, 1, At, B1); PG8_BAR;
            }
        }
        if constexpr (ALIGN_EPI) { if (wr == 0) PG8_BAR; }
        if constexpr (!Epi::AFTER_DRAIN) { E(acc, cur, wr, wc, fr, fq); S.done(cur); }
        if (!has_next) break;
#pragma unroll
        for (int a = 0; a < 2; ++a)
#pragma unroll
            for (int b = 0; b < 2; ++b)
#pragma unroll
                for (int m = 0; m < 4; ++m)
#pragma unroll
                    for (int n = 0; n < 2; ++n) acc[a][b][m][n] = (f32x4){0.f, 0.f, 0.f, 0.f};
        cur = nxt; cA = nA; cB = nB; ++ui;
        if constexpr (ALIGN_EPI) { if (wr == 1) PG8_BAR; }
    }
    PG8_WAIT_V(0);
    if constexpr (!ALIGN_EPI) { if (wr == 0) PG8_BAR; }
    PG8_BAR;
    if constexpr (Epi::AFTER_DRAIN) { E.fused(acc, cur, wr, wc, fr, fq, lds, wid, lane); S.done(cur); }
#undef PG8_SA
#undef PG8_SB
#undef PG8_STAGE
#undef PG8_LDA
#undef PG8_LDB
#undef PG8_MMA
#undef PG8_WAIT_V
#undef PG8_WAIT_L
#undef PG8_BAR
#undef PG8_SCHED
}
}

constexpr int NWAVES = 8, NTHR = NWAVES * 64;
constexpr int NT = 8192, DM = 2048, SEQ = 2048, NB = 4;
constexpr int INC = 7176, PROJW = 7168;
constexpr int NEXP = 16384;
constexpr float EPS = 1e-6f;
constexpr size_t MiB = 1u << 20;
constexpr size_t WS_CTL = 0, CTL_ZERO_BYTES = 1 * MiB;
constexpr size_t WS_WIN = 2 * MiB, WS_WOUT = 30 * MiB, WS_WQ = 38 * MiB, WS_WG = 46 * MiB, WS_WP = 54 * MiB, WS_KEYS = 55 * MiB, WS_P16 = 56 * MiB;
constexpr size_t WS_GI = 60 * MiB, WS_BLOC = 61 * MiB, WS_MT = 61 * MiB + 512 * 1024, WS_SCAL = 62 * MiB, WS_LBUF = 62 * MiB + 256 * 1024, WS_NBUF = 62 * MiB + 512 * 1024;
constexpr size_t WS_PART = 63 * MiB, WS_PART2 = 64 * MiB, WS_IDX = 65 * MiB, WS_GW = 69 * MiB;
constexpr size_t WS_U8 = 80 * MiB, WS_V8 = 112 * MiB;
constexpr size_t WS_XN = 208 * MiB;
constexpr size_t WS_PROJ = 240 * MiB, WS_PP = 352 * MiB;
constexpr size_t WS_Y = 384 * MiB;
constexpr size_t WS_UBUF = 416 * MiB;
constexpr size_t WS_END = 480 * MiB;
constexpr int CW_BAR = 4096;
constexpr int LDS_BYTES = 147456;
constexpr int R0_OFF = 0, R1_OFF = 69632, ARR_OFF = 139264, RS_OFF = 145408, MISC_OFF = 146432;

#define GAS __attribute__((address_space(1)))
#define LAS __attribute__((address_space(3)))
typedef unsigned short bf16;
typedef unsigned v4u __attribute__((ext_vector_type(4)));
typedef unsigned v2u __attribute__((ext_vector_type(2)));
typedef float f32x4 __attribute__((ext_vector_type(4)));
typedef short bf16x8 __attribute__((ext_vector_type(8)));
#define LDS_WAIT() asm volatile("s_waitcnt lgkmcnt(0)" ::: "memory")
__device__ __forceinline__ unsigned f2bf(float f) { unsigned u = __builtin_bit_cast(unsigned, f); return (u + 0x7fffu + ((u >> 16) & 1u)) >> 16; }
__device__ __forceinline__ unsigned pk2(float lo, float hi) { return f2bf(lo) | (f2bf(hi) << 16); }
__device__ __forceinline__ float bflo(unsigned w) { return __uint_as_float(w << 16); }
__device__ __forceinline__ float bfhi(unsigned w) { return __uint_as_float(w & 0xffff0000u); }
__device__ __forceinline__ float wave_sum(float v) {
#pragma unroll
    for (int o = 1; o < 64; o <<= 1) v += __shfl_xor(v, o);
    return v;
}

#define XB_TMO      128
#define XB_XCNT(j)  (256  + 64 * (j))
#define XB_XSUB(j)  (1280 + 64 * (j))
#define XB_XGEN(j)  (2304 + 64 * (j))
#define XB_TOP      3328
#define XB_TOPGEN   3392
#define XCD_BAR_WORDS 3456
#define XB_SPIN_CAP (1u << 18)
__device__ __forceinline__ unsigned xb_ld(unsigned* p)              { return __hip_atomic_load(p, __ATOMIC_RELAXED, __HIP_MEMORY_SCOPE_AGENT); }
__device__ __forceinline__ unsigned xb_add(unsigned* p, unsigned v) { return __hip_atomic_fetch_add(p, v, __ATOMIC_RELAXED, __HIP_MEMORY_SCOPE_AGENT); }
__device__ __forceinline__ unsigned xb_xcc_id() { return (unsigned)__builtin_amdgcn_s_getreg((3 << 11) | 20) & 0xFu; }
#define XB_SPIN(cond, bar) do { unsigned _sp = 0; while (cond) { __builtin_amdgcn_s_sleep(1); \
    if ((++_sp & 255u) == 0u) { if (xb_ld(&(bar)[XB_TMO])) break; if (_sp > XB_SPIN_CAP) { atomicAdd(&(bar)[XB_TMO], 1u); break; } } } } while (0)
struct XcdBarrier { unsigned* bar; unsigned x; volatile LAS unsigned* st; };
__device__ __forceinline__ XcdBarrier xcd_barrier_post(unsigned* bar, volatile LAS unsigned* st) {
    XcdBarrier b; b.bar = bar; b.x = xb_xcc_id(); b.st = st;
    if (threadIdx.x == 0) (void)xb_add(&bar[XB_XCNT(b.x)], 1u);
    return b;
}
__device__ __forceinline__ void xcd_barrier_complete(unsigned* bar, unsigned x, unsigned& nloc, unsigned& nx) {
    const unsigned G = gridDim.x * gridDim.y * gridDim.z;
    unsigned sum, cnt, mine, sp = 0u;
    for (;;) {
        sum = 0u; cnt = 0u; mine = 0u;
#pragma unroll
        for (unsigned j = 0; j < 16; ++j) { const unsigned c = xb_ld(&bar[XB_XCNT(j)]); sum += c; cnt += (c > 0u) ? 1u : 0u; mine = (j == x) ? c : mine; }
        if (sum == G) break;
        __builtin_amdgcn_s_sleep(1);
        if ((++sp & 255u) == 0u) { if (xb_ld(&bar[XB_TMO])) break; if (sp > XB_SPIN_CAP) { atomicAdd(&bar[XB_TMO], 1u); break; } }
    }
    nloc = mine > 0u ? mine : 1u; nx = cnt > 0u ? cnt : 1u;
}
__device__ __forceinline__ void xcd_barrier(const XcdBarrier& b) {
    asm volatile("s_waitcnt vmcnt(0)" ::: "memory");
    __syncthreads();
    if (threadIdx.x == 0) {
        unsigned* bar = b.bar;
        __builtin_amdgcn_s_waitcnt(0);
        unsigned nloc = b.st[0], nx = b.st[1];
        if (nloc == 0u) { xcd_barrier_complete(bar, b.x, nloc, nx); b.st[0] = nloc; b.st[1] = nx; }
        const unsigned old = xb_add(&bar[XB_XSUB(b.x)], 1u);
        const unsigned gen = old / nloc;
        if (old + 1u == (gen + 1u) * nloc) {
            __builtin_amdgcn_fence(__ATOMIC_RELEASE, "agent");
            asm volatile("s_waitcnt vmcnt(0)" ::: "memory");
            const unsigned og = xb_add(&bar[XB_TOP], 1u);
            const unsigned tg = og / nx;
            if (og + 1u == (tg + 1u) * nx) xb_add(&bar[XB_TOPGEN], 1u);
            else XB_SPIN(xb_ld(&bar[XB_TOPGEN]) == tg, bar);
            __builtin_amdgcn_fence(__ATOMIC_ACQUIRE, "agent");
            xb_add(&bar[XB_XGEN(b.x)], 1u);
            asm volatile("s_waitcnt vmcnt(0)" ::: "memory");
        } else {
            XB_SPIN(xb_ld(&bar[XB_XGEN(b.x)]) == gen, bar);
            __builtin_amdgcn_fence(__ATOMIC_ACQUIRE, "agent");
            asm volatile("s_waitcnt vmcnt(0)" ::: "memory");
        }
    }
    __syncthreads();
}

struct Args { const float* in[17]; float* out; unsigned char* ws; unsigned long long pad; };

__device__ __forceinline__ void p0_transpose_item(const float* W, int ldw, int K, bf16* WT, int nblk, int item, LAS float* scr, int lane, const float* kscale) {
    const int kb = item / nblk, nb = item % nblk, k0 = 64 * kb, n0 = 32 * nb;
#pragma unroll 8
    for (int i = 0; i < 32; ++i) { const int kk = 2 * i + (lane >> 5); float v = W[(size_t)(k0 + kk) * ldw + n0 + (lane & 31)]; if (kscale) v *= kscale[k0 + kk]; scr[kk * 33 + (lane & 31)] = v; }
    LDS_WAIT(); asm volatile("" ::: "memory");
    const int c = lane & 7;
#pragma unroll
    for (int j = 0; j < 4; ++j) { const int n = (lane >> 3) + 8 * j; const LAS float* s = scr + (8 * c) * 33 + n;
        v4u o; o.x = pk2(s[0 * 33], s[1 * 33]); o.y = pk2(s[2 * 33], s[3 * 33]); o.z = pk2(s[4 * 33], s[5 * 33]); o.w = pk2(s[6 * 33], s[7 * 33]);
        *(GAS v4u*)(WT + (size_t)(n0 + n) * K + k0 + 8 * c) = o; }
    LDS_WAIT(); asm volatile("" ::: "memory");
}
__device__ __forceinline__ void cvt_stream(const float* src, bf16* dst, size_t n8, size_t gtid, size_t nthr) {
    for (size_t i = gtid; i < n8; i += nthr) { const f32x4 a = ((const GAS f32x4*)src)[2 * i], b = ((const GAS f32x4*)src)[2 * i + 1];
        v4u o; o.x = pk2(a.x, a.y); o.y = pk2(a.z, a.w); o.z = pk2(b.x, b.y); o.w = pk2(b.z, b.w); ((GAS v4u*)dst)[i] = o; }
}
__device__ __forceinline__ void cvt_stream_fp8(const float* src, unsigned char* dst, size_t n16, size_t gtid, size_t nthr) {
#pragma unroll 2
    for (size_t i = gtid; i < n16; i += nthr) { const GAS f32x4* s = (const GAS f32x4*)src + 4 * i; v4u o;
#pragma unroll
        for (int q = 0; q < 4; ++q) { const f32x4 a = s[q] * 256.0f; int w = 0; w = __builtin_amdgcn_cvt_pk_fp8_f32(a.x, a.y, w, false); w = __builtin_amdgcn_cvt_pk_fp8_f32(a.z, a.w, w, true); o[q] = (unsigned)w; }
        ((GAS v4u*)dst)[i] = o; }
}
__device__ __forceinline__ float log_sigmoid(float x) { return fminf(x, 0.f) - log1pf(expf(-fabsf(x))); }

__device__ __forceinline__ void phase0(const Args& A, LAS unsigned char* lds, int tid, int lane, int wave) {
    unsigned char* ws = A.ws;
    const int G = gridDim.x, gw = blockIdx.x * NWAVES + wave, NGW = G * NWAVES;
    const size_t gtid = (size_t)blockIdx.x * NTHR + tid, nthr = (size_t)G * NTHR;
    {
        LAS float* scr = (LAS float*)(lds + wave * 16384);
        constexpr int I_IN = 32 * 224, I_SQ = 32 * 64, I_P = 4 * 64;
        constexpr int NITEMS = I_IN + 3 * I_SQ + I_P;
        for (int it = gw; it < NITEMS; it += NGW) {
            int r = it;
            if (r < I_IN) { p0_transpose_item(A.in[3], INC, DM, (bf16*)(ws + WS_WIN), 224, r, scr, lane, nullptr); continue; } r -= I_IN;
            if (r < I_SQ) { p0_transpose_item(A.in[7], DM, DM, (bf16*)(ws + WS_WOUT), 64, r, scr, lane, nullptr); continue; } r -= I_SQ;
            if (r < I_SQ) { p0_transpose_item(A.in[9], DM, DM, (bf16*)(ws + WS_WQ), 64, r, scr, lane, A.in[8]); continue; } r -= I_SQ;
            if (r < I_SQ) { p0_transpose_item(A.in[14], DM, DM, (bf16*)(ws + WS_WG), 64, r, scr, lane, nullptr); continue; } r -= I_SQ;
            p0_transpose_item(A.in[15], DM, 256, (bf16*)(ws + WS_WP), 64, r, scr, lane, nullptr);
        }
    }
    cvt_stream(A.in[10], (bf16*)(ws + WS_KEYS), (size_t)8 * 2 * 128 * 128 / 8, gtid, nthr);
    cvt_stream(A.in[1], (bf16*)(ws + WS_P16), (size_t)NT * 256 / 8, gtid, nthr);
    cvt_stream_fp8(A.in[11], ws + WS_U8, (size_t)NEXP * DM / 16, gtid, nthr);
    cvt_stream_fp8(A.in[12], ws + WS_V8, (size_t)NEXP * DM / 16, gtid, nthr);
    __syncthreads();
    LAS float* wg8 = (LAS float*)lds;
    for (int i = tid; i < DM * 8; i += NTHR) wg8[i] = A.in[3][(size_t)(i >> 3) * INC + PROJW + (i & 7)];
    __syncthreads();
    {
        const float* x = A.in[0]; const float* g = A.in[2]; const float* gb = A.in[5];
        bf16* XN = (bf16*)(ws + WS_XN); float* GI = (float*)(ws + WS_GI);
        f32x4 gv[8];
#pragma unroll
        for (int j = 0; j < 8; ++j) gv[j] = ((const GAS f32x4*)g)[lane + 64 * j];
        for (int t = gw; t < NT; t += NGW) {
            const GAS f32x4* xr = (const GAS f32x4*)(x + (size_t)t * DM) + lane;
            f32x4 v[8]; float ss = 0.f;
#pragma unroll
            for (int j = 0; j < 8; ++j) { v[j] = xr[64 * j]; ss += (v[j].x * v[j].x + v[j].y * v[j].y) + (v[j].z * v[j].z + v[j].w * v[j].w); }
            const float rstd = 1.0f / sqrtf(wave_sum(ss) * (1.0f / DM) + EPS);
            float ga[8];
#pragma unroll
            for (int c = 0; c < 8; ++c) ga[c] = 0.f;
            GAS v2u* o8 = (GAS v2u*)(XN + (size_t)t * DM) + lane;
#pragma unroll
            for (int j = 0; j < 8; ++j) {
                f32x4 xn = v[j] * rstd * gv[j];
                v2u o; o.x = pk2(xn.x, xn.y); o.y = pk2(xn.z, xn.w); o8[64 * j] = o;
#pragma unroll
                for (int i = 0; i < 4; ++i) { const int e = 4 * lane + 256 * j + i; const f32x4 w0 = *(const LAS f32x4*)(wg8 + e * 8), w1 = *(const LAS f32x4*)(wg8 + e * 8 + 4); const float xv = xn[i];
                    ga[0] += xv * w0.x; ga[1] += xv * w0.y; ga[2] += xv * w0.z; ga[3] += xv * w0.w; ga[4] += xv * w1.x; ga[5] += xv * w1.y; ga[6] += xv * w1.z; ga[7] += xv * w1.w; }
                asm volatile("" ::: "memory");
            }
            float outv = 0.f;
#pragma unroll
            for (int c = 0; c < 8; ++c) { const float s = wave_sum(ga[c]); if (lane == c) outv = s; }
            if (lane < 8) { float val = outv + gb[lane]; if (lane >= 4) val = log_sigmoid(val); GI[(size_t)t * 8 + lane] = val; }
        }
    }
}

constexpr int TRS = 272;
constexpr int NRS = 528;
constexpr int A_BL = 0, A_PML = 16, A_BS = 32, A_IS = 160, A_PMS = 288, A_WV = 416, A_MT = 544, A_NL = 672;

__device__ __forceinline__ void phase_x1(const Args& A, LAS unsigned char* lds, int tid, int lane, int wave) {
    unsigned char* ws = A.ws;
    const float* GI = (const float*)(ws + WS_GI); const bf16* PROJ = (const bf16*)(ws + WS_PROJ);
    float* BLOC = (float*)(ws + WS_BLOC); float* MT = (float*)(ws + WS_MT); float* SCAL = (float*)(ws + WS_SCAL); float* LBUF = (float*)(ws + WS_LBUF); float* UBUF = (float*)(ws + WS_UBUF);
    LAS float* arr = (LAS float*)(lds + ARR_OFF);
    const int lm = lane & 15, g = lane >> 4;
    for (int u = blockIdx.x; u < 256; u += gridDim.x) {
        const int c = u & 15, h = (u >> 4) & 3, b = u >> 6;
        const int t0 = b * SEQ + c * 128;
        __syncthreads();
#pragma unroll
        for (int rep = 0; rep < 2; ++rep) {
            const int cc = wave + 8 * rep;
            if (cc <= c) {
                const size_t tt = (size_t)(b * SEQ + cc * 128 + 2 * lane);
                const float i0 = GI[tt * 8 + h], i1 = GI[(tt + 1) * 8 + h], lf0 = GI[tt * 8 + 4 + h], lf1 = GI[(tt + 1) * 8 + 4 + h];
                const float p = lf0 + lf1; float incl = p;
#pragma unroll
                for (int o = 1; o < 64; o <<= 1) { const float y = __shfl_up(incl, o); if (lane >= o) incl += y; }
                const float excl = incl - p, b0 = excl + lf0, b1 = incl;
                const float g0 = i0 - b0, g1 = i1 - b1, q = fmaxf(g0, g1); float im = q;
#pragma unroll
                for (int o = 1; o < 64; o <<= 1) { const float y = __shfl_up(im, o); if (lane >= o) im = fmaxf(im, y); }
                float em = __shfl_up(im, 1); if (lane == 0) em = -INFINITY;
                if (lane == 63) { arr[A_BL + cc] = incl; arr[A_PML + cc] = im; }
                if (cc == c) { arr[A_BS + 2 * lane] = b0; arr[A_BS + 2 * lane + 1] = b1; arr[A_IS + 2 * lane] = i0; arr[A_IS + 2 * lane + 1] = i1;
                    arr[A_PMS + 2 * lane] = fmaxf(em, g0); arr[A_PMS + 2 * lane + 1] = im; }
            }
        }
        __syncthreads();
        float mprev = 0.f;
        for (int cc = 0; cc < c; ++cc) mprev = arr[A_BL + cc] + fmaxf(mprev, arr[A_PML + cc]);
        const float blast = arr[A_BL + c];
        const float mnew = arr[A_BS + 127] + fmaxf(mprev, arr[A_PMS + 127]);
        if (tid < 128) {
            const float bt = arr[A_BS + tid], mt = bt + fmaxf(mprev, arr[A_PMS + tid]);
            arr[A_WV + tid] = expf(blast - bt + arr[A_IS + tid] - mnew) * 0.0625f;
            BLOC[(size_t)(t0 + tid) * 4 + h] = bt; MT[(size_t)(t0 + tid) * 4 + h] = mt;
        }
        if (tid == 0) { SCAL[u * 4 + 0] = expf(blast + mprev - mnew); SCAL[u * 4 + 1] = mprev; }
        __syncthreads();
#pragma unroll
        for (int it = 0; it < 4; ++it) {
            const int d0 = (wave * 4 + it) * 8;
            const bf16* r0p = PROJ + (size_t)(t0 + 2 * lane) * PROJW + h * 256 + d0;
            const v4u k0 = *(const GAS v4u*)(r0p + 4096), k1 = *(const GAS v4u*)(r0p + 4096 + PROJW);
            const v4u v0 = *(const GAS v4u*)(r0p + 5120), v1 = *(const GAS v4u*)(r0p + 5120 + PROJW);
            const float w0 = arr[A_WV + 2 * lane], w1 = arr[A_WV + 2 * lane + 1];
#pragma unroll
            for (int j = 0; j < 4; ++j) {
                const unsigned ka = k0[j], kb = k1[j], va = v0[j], vb = v1[j];
                *(LAS unsigned*)(lds + R0_OFF + (d0 + 2 * j) * TRS + 4 * lane) = (ka & 0xffffu) | (kb << 16);
                *(LAS unsigned*)(lds + R0_OFF + (d0 + 2 * j + 1) * TRS + 4 * lane) = (ka >> 16) | (kb & 0xffff0000u);
                *(LAS unsigned*)(lds + R1_OFF + (d0 + 2 * j) * TRS + 4 * lane) = pk2(bflo(va) * w0, bflo(vb) * w1);
                *(LAS unsigned*)(lds + R1_OFF + (d0 + 2 * j + 1) * TRS + 4 * lane) = pk2(bfhi(va) * w0, bfhi(vb) * w1);
            }
        }
        __syncthreads();
        if (tid < 256) {
            float s = 0.f;
#pragma unroll 4
            for (int s8 = 0; s8 < 16; ++s8) { const v4u kv = *(const LAS v4u*)(lds + R0_OFF + tid * TRS + s8 * 16);
#pragma unroll
                for (int j = 0; j < 4; ++j) s += bflo(kv[j]) * arr[A_WV + s8 * 8 + 2 * j] + bfhi(kv[j]) * arr[A_WV + s8 * 8 + 2 * j + 1]; }
            LBUF[u * 256 + tid] = s;
        }
        float* Uo = UBUF + (size_t)u * 65536;
#pragma unroll 1
        for (int dh = 0; dh < 2; ++dh) {
            f32x4 acc[2][8];
#pragma unroll
            for (int i = 0; i < 2; ++i)
#pragma unroll
                for (int j = 0; j < 8; ++j) acc[i][j] = (f32x4){0.f, 0.f, 0.f, 0.f};
#pragma unroll
            for (int kk = 0; kk < 4; ++kk) {
                bf16x8 af[2];
#pragma unroll
                for (int i = 0; i < 2; ++i) af[i] = *(const LAS bf16x8*)(lds + R1_OFF + (32 * wave + 16 * i + lm) * TRS + (32 * kk + 8 * g) * 2);
#pragma unroll
                for (int j = 0; j < 8; ++j) { const bf16x8 bfr = *(const LAS bf16x8*)(lds + R0_OFF + (128 * dh + 16 * j + lm) * TRS + (32 * kk + 8 * g) * 2);
#pragma unroll
                    for (int i = 0; i < 2; ++i) acc[i][j] = __builtin_amdgcn_mfma_f32_16x16x32_bf16(af[i], bfr, acc[i][j], 0, 0, 0); }
            }
#pragma unroll
            for (int i = 0; i < 2; ++i)
#pragma unroll
                for (int j = 0; j < 8; ++j)
#pragma unroll
                    for (int r = 0; r < 4; ++r) Uo[(size_t)(32 * wave + 16 * i + 4 * g + r) * 256 + 128 * dh + 16 * j + lm] = acc[i][j][r];
        }
    }
}

__device__ __forceinline__ void phase_x2(const Args& A, int tid) {
    unsigned char* ws = A.ws;
    const float* SCAL = (const float*)(ws + WS_SCAL); const float* LBUF = (const float*)(ws + WS_LBUF); const float* UBUF = (const float*)(ws + WS_UBUF);
    float* NBUF = (float*)(ws + WS_NBUF); bf16* CT = (bf16*)(ws + WS_XN);
    const bf16* PROJ = (const bf16*)(ws + WS_PROJ); bf16* Y = (bf16*)(ws + WS_Y);
    const size_t gtid = (size_t)blockIdx.x * NTHR + tid, nthr = (size_t)gridDim.x * NTHR;
    for (size_t it = gtid; it < (size_t)16 * 16384; it += nthr) {
        const int bh = (int)(it >> 14), r = (int)(it & 16383);
        f32x4 C = (f32x4){0.f, 0.f, 0.f, 0.f};
#pragma unroll 5
        for (int c = 0; c < 15; ++c) { const int u = bh * 16 + c; const float a = SCAL[u * 4];
            const f32x4 uv = *(const GAS f32x4*)(UBUF + (size_t)u * 65536 + (size_t)r * 4); C = C * a + uv;
            v2u o; o.x = pk2(C.x, C.y); o.y = pk2(C.z, C.w); *(GAS v2u*)(CT + (size_t)(u + 1) * 65536 + (size_t)r * 4) = o; }
    }
    for (size_t it = gtid; it < 4096; it += nthr) {
        const int bh = (int)(it >> 8), d = (int)(it & 255); float n = 0.f;
        for (int c = 0; c < 15; ++c) { const int u = bh * 16 + c; n = n * SCAL[u * 4] + LBUF[u * 256 + d]; NBUF[(u + 1) * 256 + d] = n; }
    }
    const float* cw = A.in[4];
    for (size_t it = gtid; it < (size_t)NT * 128; it += nthr) {
        const int t = (int)(it >> 7), c0 = (int)(it & 127) * 8, s = t & (SEQ - 1);
        const bf16* row = PROJ + (size_t)t * PROJW + c0;
        const v4u bc = *(const GAS v4u*)row, cc0 = *(const GAS v4u*)(row + 1024), uc0 = *(const GAS v4u*)(row + 2048);
        v4u cc1 = (v4u){0, 0, 0, 0}, uc1 = cc1, cc2 = cc1, uc2 = cc1;
        if (s >= 1) { cc1 = *(const GAS v4u*)(row - PROJW + 1024); uc1 = *(const GAS v4u*)(row - PROJW + 2048); }
        if (s >= 2) { cc2 = *(const GAS v4u*)(row - 2 * PROJW + 1024); uc2 = *(const GAS v4u*)(row - 2 * PROJW + 2048); }
        float w0[8], w1[8], w2[8];
#pragma unroll
        for (int i = 0; i < 8; ++i) { w0[i] = cw[c0 + i]; w1[i] = cw[1024 + c0 + i]; w2[i] = cw[2048 + c0 + i]; }
        v4u o;
#pragma unroll
        for (int j = 0; j < 4; ++j) {
            const float ylo = bflo(bc[j]) * (w0[2 * j] * (bflo(cc2[j]) * bflo(uc2[j])) + w1[2 * j] * (bflo(cc1[j]) * bflo(uc1[j])) + w2[2 * j] * (bflo(cc0[j]) * bflo(uc0[j])));
            const float yhi = bfhi(bc[j]) * (w0[2 * j + 1] * (bfhi(cc2[j]) * bfhi(uc2[j])) + w1[2 * j + 1] * (bfhi(cc1[j]) * bfhi(uc1[j])) + w2[2 * j + 1] * (bfhi(cc0[j]) * bfhi(uc0[j])));
            o[j] = pk2(ylo, yhi);
        }
        *(GAS v4u*)(Y + (size_t)t * DM + c0) = o;
    }
}

__device__ __forceinline__ void phase_x3(const Args& A, LAS unsigned char* lds, int tid, int lane, int wave) {
    unsigned char* ws = A.ws;
    const float* GI = (const float*)(ws + WS_GI); const bf16* PROJ = (const bf16*)(ws + WS_PROJ);
    const float* BLOC = (const float*)(ws + WS_BLOC); const float* MT = (const float*)(ws + WS_MT); const float* SCAL = (const float*)(ws + WS_SCAL); const float* NBUF = (const float*)(ws + WS_NBUF);
    const bf16* CT = (const bf16*)(ws + WS_XN); bf16* Y = (bf16*)(ws + WS_Y);
    const float* gm = A.in[6];
    LAS float* arr = (LAS float*)(lds + ARR_OFF);
    const int lm = lane & 15, g = lane >> 4;
    for (int u = blockIdx.x; u < 256; u += gridDim.x) {
        const int c = u & 15, h = (u >> 4) & 3, b = u >> 6;
        const int t0 = b * SEQ + c * 128;
        const float mprev = SCAL[u * 4 + 1];
        __syncthreads();
        if (tid < 128) { arr[A_BS + tid] = BLOC[(size_t)(t0 + tid) * 4 + h]; arr[A_MT + tid] = MT[(size_t)(t0 + tid) * 4 + h]; arr[A_IS + tid] = GI[(size_t)(t0 + tid) * 8 + h]; }
        if (tid < 256) arr[A_NL + tid] = (c > 0) ? NBUF[u * 256 + tid] : 0.f;
        const bf16* qp = PROJ + (size_t)(t0 + 16 * wave + lm) * PROJW + 3072 + h * 256 + 8 * g;
        float qn = 0.f;
        f32x4 acc[16];
#pragma unroll
        for (int j = 0; j < 16; ++j) acc[j] = (f32x4){0.f, 0.f, 0.f, 0.f};
        if (c > 0) {
            const bf16* ct = CT + (size_t)u * 65536;
#pragma unroll 4
            for (int i = 0; i < 16; ++i) { const int q = tid + NTHR * i, e = q >> 5, ch = q & 31;
                const v4u v = *(const GAS v4u*)(ct + (size_t)e * 256 + ch * 8);
                *(LAS v4u*)(lds + (e < 128 ? R0_OFF + e * NRS : R1_OFF + (e - 128) * NRS) + ch * 16) = v; }
            __syncthreads();
            bf16x8 qa = *(const GAS bf16x8*)qp;
#pragma unroll
            for (int kk = 0; kk < 8; ++kk) {
                const bf16x8 qnx = *(const GAS bf16x8*)(qp + 32 * (kk < 7 ? kk + 1 : 7));
#pragma unroll
                for (int j = 0; j < 16; ++j) { const bf16x8 bfr = *(const LAS bf16x8*)(lds + (j < 8 ? R0_OFF : R1_OFF) + (16 * (j & 7) + lm) * NRS + (32 * kk + 8 * g) * 2);
                    acc[j] = __builtin_amdgcn_mfma_f32_16x16x32_bf16(qa, bfr, acc[j], 0, 0, 0); }
#pragma unroll
                for (int jj = 0; jj < 8; ++jj) qn += __uint_as_float(((unsigned)(unsigned short)qa[jj]) << 16) * arr[A_NL + 32 * kk + 8 * g + jj];
                asm volatile("" ::: "memory");
                qa = qnx;
            }
        } else { __syncthreads(); }
        float at[4];
#pragma unroll
        for (int r = 0; r < 4; ++r) { const int t = 16 * wave + 4 * g + r; at[r] = expf(arr[A_BS + t] + mprev - arr[A_MT + t]); }
        qn += __shfl_xor(qn, 16); qn += __shfl_xor(qn, 32);
#pragma unroll
        for (int j = 0; j < 16; ++j)
#pragma unroll
            for (int r = 0; r < 4; ++r) acc[j][r] *= at[r];
        __syncthreads();
        {
#pragma unroll
            for (int i = 0; i < 8; ++i) { const int q = tid + NTHR * i, s = q >> 5, ch = q & 31;
                const v4u v = *(const GAS v4u*)(PROJ + (size_t)(t0 + s) * PROJW + 4096 + h * 256 + ch * 8);
                *(LAS v4u*)(lds + R0_OFF + s * NRS + ch * 16) = v; }
#pragma unroll
            for (int it = 0; it < 4; ++it) {
                const int d0 = (wave * 4 + it) * 8;
                const bf16* r0p = PROJ + (size_t)(t0 + 2 * lane) * PROJW + 5120 + h * 256 + d0;
                const v4u v0 = *(const GAS v4u*)r0p, v1 = *(const GAS v4u*)(r0p + PROJW);
#pragma unroll
                for (int j = 0; j < 4; ++j) {
                    const unsigned va = v0[j], vb = v1[j];
                    *(LAS unsigned*)(lds + R1_OFF + (d0 + 2 * j) * TRS + 4 * lane) = (va & 0xffffu) | (vb << 16);
                    *(LAS unsigned*)(lds + R1_OFF + (d0 + 2 * j + 1) * TRS + 4 * lane) = (va >> 16) | (vb & 0xffff0000u);
                }
            }
        }
        __syncthreads();
        f32x4 sacc[8];
#pragma unroll
        for (int j = 0; j < 8; ++j) sacc[j] = (f32x4){0.f, 0.f, 0.f, 0.f};
        {
            bf16x8 qa = *(const GAS bf16x8*)qp;
#pragma unroll
            for (int kk = 0; kk < 8; ++kk) {
                const bf16x8 qnx = *(const GAS bf16x8*)(qp + 32 * (kk < 7 ? kk + 1 : 7));
#pragma unroll
                for (int j = 0; j < 8; ++j) { const bf16x8 bfr = *(const LAS bf16x8*)(lds + R0_OFF + (16 * j + lm) * NRS + (32 * kk + 8 * g) * 2);
                    sacc[j] = __builtin_amdgcn_mfma_f32_16x16x32_bf16(qa, bfr, sacc[j], 0, 0, 0); }
                asm volatile("" ::: "memory");
                qa = qnx;
            }
        }
        float rb[4], mtr[4], dsum[4];
#pragma unroll
        for (int r = 0; r < 4; ++r) { const int t = 16 * wave + 4 * g + r; mtr[r] = arr[A_MT + t]; rb[r] = arr[A_BS + t] - mtr[r]; dsum[r] = 0.f; }
#pragma unroll
        for (int j = 0; j < 8; ++j) { const int s = 16 * j + lm; const float cb = arr[A_IS + s] - arr[A_BS + s];
#pragma unroll
            for (int r = 0; r < 4; ++r) { const int t = 16 * wave + 4 * g + r; const float p = (s <= t) ? sacc[j][r] * 0.0625f * __expf(rb[r] + cb) : 0.f; sacc[j][r] = p; dsum[r] += p; } }
#pragma unroll
        for (int r = 0; r < 4; ++r) { float d = dsum[r]; d += __shfl_xor(d, 1); d += __shfl_xor(d, 2); d += __shfl_xor(d, 4); d += __shfl_xor(d, 8); dsum[r] = d; }
        __syncthreads();
#pragma unroll
        for (int j = 0; j < 8; ++j)
#pragma unroll
            for (int r = 0; r < 4; ++r) *(LAS unsigned short*)(lds + R0_OFF + (16 * wave + 4 * g + r) * TRS + (16 * j + lm) * 2) = (unsigned short)f2bf(sacc[j][r]);
        __syncthreads();
#pragma unroll
        for (int kk = 0; kk < 4; ++kk) {
            const bf16x8 pa = *(const LAS bf16x8*)(lds + R0_OFF + (16 * wave + lm) * TRS + (32 * kk + 8 * g) * 2);
#pragma unroll
            for (int j = 0; j < 16; ++j) { const bf16x8 vb = *(const LAS bf16x8*)(lds + R1_OFF + (16 * j + lm) * TRS + (32 * kk + 8 * g) * 2);
                acc[j] = __builtin_amdgcn_mfma_f32_16x16x32_bf16(pa, vb, acc[j], 0, 0, 0); }
            asm volatile("" ::: "memory");
        }
        float ssq[4], inv[4];
#pragma unroll
        for (int r = 0; r < 4; ++r) { const float qnr = __shfl(qn, 4 * g + r); const float den = at[r] * qnr + dsum[r]; inv[r] = 1.0f / fmaxf(fabsf(den), expf(-mtr[r])); ssq[r] = 0.f; }
#pragma unroll
        for (int j = 0; j < 16; ++j)
#pragma unroll
            for (int r = 0; r < 4; ++r) { const float hv = acc[j][r] * inv[r]; acc[j][r] = hv; ssq[r] += hv * hv; }
#pragma unroll
        for (int r = 0; r < 4; ++r) { float d = ssq[r]; d += __shfl_xor(d, 1); d += __shfl_xor(d, 2); d += __shfl_xor(d, 4); d += __shfl_xor(d, 8); ssq[r] = 1.0f / sqrtf(d * (1.0f / 256.0f) + EPS); }
#pragma unroll
        for (int j = 0; j < 16; ++j) { const int e = 16 * j + lm; const float gmv = gm[h * 256 + e];
#pragma unroll
            for (int r = 0; r < 4; ++r) { const size_t tg = (size_t)(t0 + 16 * wave + 4 * g + r);
                const float o = __uint_as_float(((unsigned)PROJ[tg * PROJW + 6144 + h * 256 + e]) << 16);
                const float yv = (acc[j][r] * ssq[r] * gmv) / (1.0f + __expf(-o));
                Y[tg * DM + 1024 + h * 256 + e] = (bf16)f2bf(yv); }
            asm volatile("" ::: "memory"); }
    }
}

__device__ __forceinline__ unsigned fkey(float v) { const unsigned u = __float_as_uint(v); return (u & 0x80000000u) ? ~u : (u | 0x80000000u); }
__device__ __forceinline__ float fdec(unsigned k) { return __uint_as_float((k & 0x80000000u) ? (k & 0x7fffffffu) : ~k); }
#define TK_CE(a, b) do { const unsigned _t = max((a), (b)); (b) = min((a), (b)); (a) = _t; } while (0)
template <int BASE> __device__ __forceinline__ void tk_sort16(unsigned (&v)[64]) {
#pragma unroll
    for (int k = 2; k <= 16; k <<= 1)
#pragma unroll
        for (int j = k >> 1; j > 0; j >>= 1)
#pragma unroll
            for (int i = 0; i < 16; ++i) { const int l = i ^ j; if (l > i) { if ((i & k) == 0) TK_CE(v[BASE + i], v[BASE + l]); else TK_CE(v[BASE + l], v[BASE + i]); } }
}
template <int A0, int B0> __device__ __forceinline__ void tk_merge16(unsigned (&v)[64]) {
#pragma unroll
    for (int i = 0; i < 16; ++i) v[A0 + i] = max(v[A0 + i], v[B0 + 15 - i]);
#pragma unroll
    for (int j = 8; j > 0; j >>= 1)
#pragma unroll
        for (int i = 0; i < 16; ++i) { const int l = i ^ j; if (l > i) TK_CE(v[A0 + i], v[A0 + l]); }
}

__device__ __forceinline__ void phase5(const Args& A, LAS unsigned char* lds, int tid, int lane, int wave) {
    unsigned char* ws = A.ws;
    const bf16* QP = (const bf16*)(ws + WS_Y); const bf16* KEYS = (const bf16*)(ws + WS_KEYS);
    int* IDX = (int*)(ws + WS_IDX); float* GW = (float*)(ws + WS_GW);
    LAS float* SC = (LAS float*)lds;
    LAS unsigned* LST = (LAS unsigned*)lds;
    const int lm = lane & 15, g = lane >> 4;
    for (int u = blockIdx.x; u < 512; u += gridDim.x) {
        const int tt = u >> 3, h = u & 7;
        __syncthreads();
#pragma unroll 1
        for (int p = 0; p < 2; ++p) {
            f32x4 sacc[8];
#pragma unroll
            for (int j = 0; j < 8; ++j) sacc[j] = (f32x4){0.f, 0.f, 0.f, 0.f};
            const bf16* qp = QP + (size_t)(tt * 128 + 16 * wave + lm) * DM + h * 256 + p * 128 + 8 * g;
            const bf16* kp = KEYS + (size_t)((h * 2 + p) * 128 + lm) * 128 + 8 * g;
#pragma unroll
            for (int kk = 0; kk < 4; ++kk) { const bf16x8 af = *(const GAS bf16x8*)(qp + 32 * kk);
#pragma unroll
                for (int j = 0; j < 8; ++j) { const bf16x8 bfr = *(const GAS bf16x8*)(kp + (size_t)(16 * j) * 128 + 32 * kk);
                    sacc[j] = __builtin_amdgcn_mfma_f32_16x16x32_bf16(af, bfr, sacc[j], 0, 0, 0); } }
#pragma unroll
            for (int j = 0; j < 8; ++j)
#pragma unroll
                for (int r = 0; r < 4; ++r) SC[(p * 128 + 16 * wave + 4 * g + r) * 129 + 16 * j + lm] = sacc[j][r];
        }
        __syncthreads();
        unsigned v[64];
        {
            const int t = (tid >> 1) & 127, half = tid & 1, p = tid >> 8;
            const LAS float* row = SC + (p * 128 + t) * 129;
#pragma unroll
            for (int i = 0; i < 64; ++i) { const int n = 64 * half + ((i + 16 * half) & 63); v[i] = (fkey(row[n]) & ~127u) | (unsigned)(127 - n); }
            tk_sort16<0>(v); tk_sort16<16>(v); tk_sort16<32>(v); tk_sort16<48>(v);
            tk_merge16<0, 16>(v); tk_merge16<32, 48>(v); tk_merge16<0, 32>(v);
#pragma unroll
            for (int j = 0; j < 16; ++j) v[16 + j] = __shfl_xor(v[j], 1);
            tk_merge16<0, 16>(v);
        }
        __syncthreads();
        if ((tid & 1) == 0) { const int t = (tid >> 1) & 127, p = tid >> 8;
#pragma unroll
            for (int j = 0; j < 4; ++j) *(LAS v4u*)(LST + (p * 128 + t) * 16 + 4 * j) = (v4u){v[4 * j], v[4 * j + 1], v[4 * j + 2], v[4 * j + 3]}; }
        __syncthreads();
        {
            const int t = tid >> 2, sub = tid & 3;
            const unsigned long long d0 = sub == 0 ? 0x0706050403020100ull : sub == 1 ? 0x1716151413121110ull : sub == 2 ? 0x5042414033323130ull : 0xf0e0d0c0b0a09080ull;
            const unsigned long long d1 = sub == 0 ? 0x0f0e0d0c0b0a0908ull : sub == 1 ? 0xffffff2423222120ull : sub == 2 ? 0xffffff7170616051ull : 0xffffffffffffffffull;
#pragma unroll
            for (int s = 0; s < 16; ++s) {
                const unsigned ij = (unsigned)((s < 8 ? d0 >> (8 * s) : d1 >> (8 * (s - 8))) & 0xffu);
                const unsigned i = ij >> 4, j = ij & 15u;
                const float sum = fdec(LST[t * 16 + i] & ~127u) + fdec(LST[(128 + t) * 16 + j] & ~127u);
                v[s] = (fkey(sum) & ~255u) | (255u - ij);
            }
            tk_sort16<0>(v);
#pragma unroll
            for (int j = 0; j < 16; ++j) v[16 + j] = __shfl_xor(v[j], 1);
            tk_merge16<0, 16>(v);
#pragma unroll
            for (int j = 0; j < 16; ++j) v[16 + j] = __shfl_xor(v[j], 2);
            tk_merge16<0, 16>(v);
            if (sub == 0) {
                float bs[16]; int ex[16];
#pragma unroll
                for (int k = 0; k < 16; ++k) { const unsigned pos = 255u - (v[k] & 255u), i = pos >> 4, j = pos & 15u;
                    const unsigned k0 = LST[t * 16 + i], k1 = LST[(128 + t) * 16 + j];
                    bs[k] = fdec(k0 & ~127u) + fdec(k1 & ~127u); ex[k] = (127 - (int)(k0 & 127u)) * 128 + (127 - (int)(k1 & 127u)); }
                float mx = bs[0];
#pragma unroll
                for (int k = 1; k < 16; ++k) mx = fmaxf(mx, bs[k]);
                float sum = 0.f;
#pragma unroll
                for (int k = 0; k < 16; ++k) { bs[k] = expf(bs[k] - mx); sum += bs[k]; }
                const float rs = 1.0f / sum;
                const size_t o = ((size_t)(tt * 128 + t) * 8 + h) * 16;
#pragma unroll
                for (int k = 0; k < 4; ++k) { *(GAS v4u*)(IDX + o + 4 * k) = (v4u){(unsigned)ex[4 * k], (unsigned)ex[4 * k + 1], (unsigned)ex[4 * k + 2], (unsigned)ex[4 * k + 3]};
                    *(GAS f32x4*)(GW + o + 4 * k) = (f32x4){bs[4 * k] * rs, bs[4 * k + 1] * rs, bs[4 * k + 2] * rs, bs[4 * k + 3] * rs}; }
            }
        }
    }
}

__device__ __forceinline__ float gelu_erf(float a) { return 0.5f * a * (1.0f + erff(a * 0.70710678118654752f)); }
typedef float f32x2 __attribute__((ext_vector_type(2)));
#define P6_B 8
__device__ __forceinline__ void phase6(const Args& A, int lane, int wave, float* Hout, bf16* XN3) {
    unsigned char* ws = A.ws;
    const int* IDX = (const int*)(ws + WS_IDX); const float* GW = (const float*)(ws + WS_GW);
    const unsigned char* U8 = ws + WS_U8; const unsigned char* V8 = ws + WS_V8;
    const float* H = (const float*)(ws + WS_UBUF); const float* PART = (const float*)(ws + WS_PART);
    const float* gf = A.in[8]; const float* gp = A.in[13];
    const int gw = blockIdx.x * NWAVES + wave, NGW = gridDim.x * NWAVES;
    const bool b5 = lane & 32, b4 = lane & 16, b3 = lane & 8;
    for (int t = gw; t < NT; t += NGW) {
        const int id0 = IDX[(size_t)t * 128 + lane], id1 = IDX[(size_t)t * 128 + 64 + lane];
        const float g0 = GW[(size_t)t * 128 + lane], g1 = GW[(size_t)t * 128 + 64 + lane];
        float ps = PART[(size_t)t * 32 + (lane & 31)];
        ps += __shfl_xor(ps, 1); ps += __shfl_xor(ps, 2); ps += __shfl_xor(ps, 4); ps += __shfl_xor(ps, 8); ps += __shfl_xor(ps, 16);
        const float rstd2 = (1.0f / 256.0f) / sqrtf(ps * (1.0f / DM) + EPS);
        f32x2 x[16];
        { const GAS f32x4* gr = (const GAS f32x4*)gf + 4 * lane; const GAS f32x4* hr = (const GAS f32x4*)(H + (size_t)t * DM) + 4 * lane;
#pragma unroll
          for (int j = 0; j < 2; ++j)
#pragma unroll
              for (int q = 0; q < 4; ++q) { const f32x4 xv = hr[256 * j + q] * rstd2 * gr[256 * j + q]; x[8 * j + 2 * q] = (f32x2){xv.x, xv.y}; x[8 * j + 2 * q + 1] = (f32x2){xv.z, xv.w}; } }
        float a0 = 0.f, a1 = 0.f;
#pragma unroll 1
        for (int kb = 0; kb < 128; kb += P6_B) {
            v4u w[P6_B][2];
#pragma unroll
            for (int q = 0; q < P6_B; ++q) { const int k = kb + q; const int e = __builtin_amdgcn_readlane(kb < 64 ? id0 : id1, k & 63);
                const GAS v4u* row = (const GAS v4u*)(U8 + (size_t)e * DM) + lane; w[q][0] = row[0]; w[q][1] = row[64]; }
            float p[P6_B];
#pragma unroll
            for (int q = 0; q < P6_B; ++q) { f32x2 acc = (f32x2){0.f, 0.f};
#pragma unroll
                for (int j = 0; j < 2; ++j)
#pragma unroll
                    for (int d = 0; d < 4; ++d) { const int wd = (int)w[q][j][d];
                        acc = __builtin_elementwise_fma(__builtin_amdgcn_cvt_pk_f32_fp8(wd, false), x[8 * j + 2 * d], acc);
                        acc = __builtin_elementwise_fma(__builtin_amdgcn_cvt_pk_f32_fp8(wd, true), x[8 * j + 2 * d + 1], acc); }
                p[q] = acc.x + acc.y; }
            float r4[4], r2[2], r1;
#pragma unroll
            for (int i = 0; i < 4; ++i) { const float snd = b5 ? p[i] : p[i + 4], kp = b5 ? p[i + 4] : p[i]; r4[i] = kp + __shfl_xor(snd, 32); }
#pragma unroll
            for (int i = 0; i < 2; ++i) { const float snd = b4 ? r4[i] : r4[i + 2], kp = b4 ? r4[i + 2] : r4[i]; r2[i] = kp + __shfl_xor(snd, 16); }
            { const float snd = b3 ? r2[0] : r2[1], kp = b3 ? r2[1] : r2[0]; r1 = kp + __shfl_xor(snd, 8); }
            r1 += __shfl_xor(r1, 4); r1 += __shfl_xor(r1, 2); r1 += __shfl_xor(r1, 1);
            const float tv = __shfl(r1, (lane & 7) << 3);
            if ((lane & 56) == (kb & 63)) { if (kb < 64) a0 = tv; else a1 = tv; }
        }
        const float w0 = gelu_erf(a0) * g0 * (1.0f / 256.0f), w1 = gelu_erf(a1) * g1 * (1.0f / 256.0f);
        f32x2 o[16];
#pragma unroll
        for (int j = 0; j < 16; ++j) o[j] = (f32x2){0.f, 0.f};
#pragma unroll 1
        for (int kb = 0; kb < 128; kb += P6_B) {
            v4u w[P6_B][2]; float wk[P6_B];
#pragma unroll
            for (int q = 0; q < P6_B; ++q) { const int k = kb + q; const int e = __builtin_amdgcn_readlane(kb < 64 ? id0 : id1, k & 63);
                wk[q] = __int_as_float(__builtin_amdgcn_readlane(__float_as_int(kb < 64 ? w0 : w1), k & 63));
                const GAS v4u* row = (const GAS v4u*)(V8 + (size_t)e * DM) + lane; w[q][0] = row[0]; w[q][1] = row[64]; }
#pragma unroll
            for (int q = 0; q < P6_B; ++q) { const f32x2 wk2 = (f32x2){wk[q], wk[q]};
#pragma unroll
                for (int j = 0; j < 2; ++j)
#pragma unroll
                    for (int d = 0; d < 4; ++d) { const int wd = (int)w[q][j][d];
                        o[8 * j + 2 * d] = __builtin_elementwise_fma(__builtin_amdgcn_cvt_pk_f32_fp8(wd, false), wk2, o[8 * j + 2 * d]);
                        o[8 * j + 2 * d + 1] = __builtin_elementwise_fma(__builtin_amdgcn_cvt_pk_f32_fp8(wd, true), wk2, o[8 * j + 2 * d + 1]); } }
        }
        float ss = 0.f; f32x4 hv[8];
        { const GAS f32x4* hr = (const GAS f32x4*)(H + (size_t)t * DM) + 4 * lane;
#pragma unroll
          for (int j = 0; j < 2; ++j)
#pragma unroll
              for (int q = 0; q < 4; ++q) { f32x4 v = hr[256 * j + q]; v.x += o[8 * j + 2 * q].x; v.y += o[8 * j + 2 * q].y; v.z += o[8 * j + 2 * q + 1].x; v.w += o[8 * j + 2 * q + 1].y; hv[4 * j + q] = v;
                  ss += (v.x * v.x + v.y * v.y) + (v.z * v.z + v.w * v.w); } }
        const float rstd3 = 1.0f / sqrtf(wave_sum(ss) * (1.0f / DM) + EPS);
        { GAS f32x4* ho = (GAS f32x4*)(Hout + (size_t)t * DM) + 4 * lane; const GAS f32x4* gr = (const GAS f32x4*)gp + 4 * lane; GAS v4u* xo = (GAS v4u*)(XN3 + (size_t)t * DM) + 2 * lane;
#pragma unroll
          for (int j = 0; j < 2; ++j) {
#pragma unroll
              for (int q = 0; q < 4; ++q) ho[256 * j + q] = hv[4 * j + q];
#pragma unroll
              for (int q = 0; q < 2; ++q) { const f32x4 ya = hv[4 * j + 2 * q] * rstd3 * gr[256 * j + 2 * q], yb = hv[4 * j + 2 * q + 1] * rstd3 * gr[256 * j + 2 * q + 1];
                  v4u ov; ov.x = pk2(ya.x, ya.y); ov.y = pk2(ya.z, ya.w); ov.z = pk2(yb.x, yb.y); ov.w = pk2(yb.z, yb.w); xo[128 * j + q] = ov; } } }
    }
}

__device__ __forceinline__ void phase8(const Args& A, int lane, int wave) {
    const float* PART2 = (const float*)(A.ws + WS_PART2); const float* gfin = A.in[16]; float* out = A.out;
    const int gw = blockIdx.x * NWAVES + wave, NGW = gridDim.x * NWAVES;
    for (int t = gw; t < NT; t += NGW) {
        float ps = PART2[(size_t)t * 32 + (lane & 31)];
        ps += __shfl_xor(ps, 1); ps += __shfl_xor(ps, 2); ps += __shfl_xor(ps, 4); ps += __shfl_xor(ps, 8); ps += __shfl_xor(ps, 16);
        const float rstd = 1.0f / sqrtf(ps * (1.0f / DM) + EPS);
        GAS f32x4* r = (GAS f32x4*)(out + (size_t)t * DM) + lane; const GAS f32x4* gr = (const GAS f32x4*)gfin + lane;
#pragma unroll
        for (int j = 0; j < 8; ++j) r[64 * j] = r[64 * j] * rstd * gr[64 * j];
    }
}

__global__ void __launch_bounds__(NTHR, 2) mk_fwd(Args args) {
    extern __shared__ __attribute__((aligned(16))) unsigned char lds_raw[];
    LAS unsigned char* lds = (LAS unsigned char*)lds_raw;
    int tid = threadIdx.x, lane = tid & 63, wave = __builtin_amdgcn_readfirstlane(tid >> 6);
#define FRESH_TID() do { tid = threadIdx.x; asm volatile("" : "+v"(tid)); lane = tid & 63; wave = __builtin_amdgcn_readfirstlane(tid >> 6); } while (0)
    volatile LAS unsigned* MISC = (volatile LAS unsigned*)(lds + MISC_OFF);
    if (tid < 32) MISC[tid] = 0u;
    __syncthreads();
    unsigned char* ws = args.ws;
    XcdBarrier bar = xcd_barrier_post((unsigned*)(ws + WS_CTL) + CW_BAR, MISC + 8);
    const int G = gridDim.x, bx = blockIdx.x;

#ifndef NO_P0
    FRESH_TID(); phase0(args, lds, tid, lane, wave);
#endif
    xcd_barrier(bar);
#ifdef DUP_P0
    FRESH_TID(); phase0(args, lds, tid, lane, wave);
    xcd_barrier(bar);
#endif
    {
        pg8::Gemm g{(const bf16*)(ws + WS_XN), (const bf16*)(ws + WS_WIN), NT, PROJW, DM}; pg8::StaticOrder S; S.init(NT, PROJW, G, bx);
        pg8::EpiBf16<0> E{(bf16*)(ws + WS_PROJ), PROJW, nullptr, 0, 0, 1.f};
        pg8::gemm_phase<pg8::EpiBf16<0>, pg8::StaticOrder, true, true>(lds, g, S, E);
        pg8::Gemm g2{(const bf16*)(ws + WS_P16), (const bf16*)(ws + WS_WP), NT, DM, 256}; pg8::StaticOrder S2; S2.init(NT, DM, G, bx);
        pg8::EpiBf16<0> E2{(bf16*)(ws + WS_PP), DM, nullptr, 0, 0, 1.f};
        pg8::gemm_phase<pg8::EpiBf16<0>, pg8::StaticOrder, true, true>(lds, g2, S2, E2);
    }
    xcd_barrier(bar);
#ifdef DUP_X
#define NREP_X 2
#else
#define NREP_X 1
#endif
#pragma unroll 1
    for (int rep = 0; rep < NREP_X; ++rep) {
#ifndef NO_X1
    FRESH_TID(); phase_x1(args, lds, tid, lane, wave);
#endif
    xcd_barrier(bar);
#ifndef NO_X2
    FRESH_TID(); phase_x2(args, tid);
#endif
    xcd_barrier(bar);
#ifndef NO_X3
    FRESH_TID(); phase_x3(args, lds, tid, lane, wave);
#endif
    xcd_barrier(bar);
    }
    {
        pg8::Gemm g{(const bf16*)(ws + WS_Y), (const bf16*)(ws + WS_WOUT), NT, DM, DM}; pg8::StaticOrder S; S.init(NT, DM, G, bx);
        pg8::EpiResidual E{args.in[0], (float*)(ws + WS_UBUF), (bf16*)(ws + WS_XN), (float*)(ws + WS_PART), DM};
        pg8::gemm_phase<pg8::EpiResidual, pg8::StaticOrder, true, true>(lds, g, S, E);
    }
    xcd_barrier(bar);
    {
        pg8::Gemm g{(const bf16*)(ws + WS_XN), (const bf16*)(ws + WS_WQ), NT, DM, DM}; pg8::StaticOrder S; S.init(NT, DM, G, bx);
        LAS float* rs = (LAS float*)(lds + RS_OFF);
        pg8::Unit u0; FRESH_TID();
        if (S.next(0, u0)) {
            const float* PART = (const float*)(ws + WS_PART);
            const int row = tid >> 1, hf = tid & 1; const float* pr = PART + (size_t)(u0.pm * 256 + row) * 32 + hf * 16; float s = 0.f;
#pragma unroll
            for (int i = 0; i < 4; ++i) { const f32x4 v = *(const GAS f32x4*)(pr + 4 * i); s += (v.x + v.y) + (v.z + v.w); }
            s += __shfl_xor(s, 1);
            if (hf == 0) rs[row] = 1.0f / sqrtf(s * (1.0f / DM) + EPS);
        }
        __syncthreads();
        pg8::EpiRowScaleBf16 E{(bf16*)(ws + WS_Y), DM, (const PG8_LAS float*)rs};
        pg8::gemm_phase<pg8::EpiRowScaleBf16, pg8::StaticOrder, true, true>(lds, g, S, E);
    }
    xcd_barrier(bar);
#ifndef NO_P5
    FRESH_TID(); phase5(args, lds, tid, lane, wave);
#endif
    xcd_barrier(bar);
#ifdef DUP_P5
    FRESH_TID(); phase5(args, lds, tid, lane, wave);
    xcd_barrier(bar);
#endif
#ifdef DUP_P6
    FRESH_TID(); phase6(args, lane, wave, (float*)(ws + WS_PROJ), (bf16*)(ws + WS_PROJ + 64 * MiB));
    xcd_barrier(bar);
#endif
#ifndef NO_P6
    FRESH_TID(); phase6(args, lane, wave, (float*)(ws + WS_UBUF), (bf16*)(ws + WS_XN));
#endif
    xcd_barrier(bar);
    {
        pg8::Gemm g{(const bf16*)(ws + WS_XN), (const bf16*)(ws + WS_WG), NT, DM, DM}; pg8::StaticOrder S; S.init(NT, DM, G, bx);
        pg8::EpiGate E{(const float*)(ws + WS_UBUF), (const bf16*)(ws + WS_PP), args.out, (float*)(ws + WS_PART2), DM};
        pg8::gemm_phase<pg8::EpiGate, pg8::StaticOrder, true, true>(lds, g, S, E);
    }
    xcd_barrier(bar);
#ifndef NO_P8
    FRESH_TID(); phase8(args, lane, wave);
#endif
}

extern "C" void kernel_launch(void* const* d_in, const int* in_sizes, int n_in, void* d_out, int out_size, void* d_ws, size_t ws_size, hipStream_t stream) {
    static int grid = 0;
    if (grid == 0) {
        if (n_in != 17 || out_size != NT * DM || ws_size < WS_END) { fprintf(stderr, "kernel_launch: unexpected shapes (n_in %d, out %d, ws %zu); nothing launched\n", n_in, out_size, ws_size); grid = -1; return; }
        int dev = 0, cus = 0, per_cu = 0;
        if (hipGetDevice(&dev) != hipSuccess || hipDeviceGetAttribute(&cus, hipDeviceAttributeMultiprocessorCount, dev) != hipSuccess) { grid = -1; return; }
        if (hipFuncSetAttribute((const void*)mk_fwd, hipFuncAttributeMaxDynamicSharedMemorySize, LDS_BYTES) != hipSuccess) { fprintf(stderr, "kernel_launch: hipFuncSetAttribute failed\n"); grid = -1; return; }
        if (hipOccupancyMaxActiveBlocksPerMultiprocessor(&per_cu, (const void*)mk_fwd, NTHR, LDS_BYTES) != hipSuccess || per_cu < 1) { fprintf(stderr, "kernel_launch: occupancy query says %d blocks per CU\n", per_cu); }
        (void)hipGetLastError();
        grid = cus;
    }
    if (grid < 0) return;
    (void)hipMemsetAsync((char*)d_ws + WS_CTL, 0, CTL_ZERO_BYTES, stream);
    Args a{};
    for (int i = 0; i < 17; ++i) a.in[i] = (const float*)d_in[i];
    a.out = (float*)d_out; a.ws = (unsigned char*)d_ws; a.pad = 0ull;
    hipLaunchKernelGGL(mk_fwd, dim3(grid), dim3(NTHR), LDS_BYTES, stream, a);
}
```

```cpp
#include <hip/hip_runtime.h>
#include <cstdio>
#include <cstdint>
#include <cmath>
namespace pg8 {
#define PG8_LAS __attribute__((address_space(3)))
typedef unsigned short bf16_t;
typedef short bf16x8 __attribute__((ext_vector_type(8)));
typedef float f32x4 __attribute__((ext_vector_type(4)));
typedef unsigned u32x4 __attribute__((ext_vector_type(4)));
constexpr int BM = 256, BK = 64, HALF = 128, HTB = HALF * BK * 2  , STAGE_BYTES = 8 * HTB, NXCD = 8, WGM = 8;

__host__ __device__ __forceinline__ int lds_byte(int r, int c) { const int st = (r >> 4) * 2 + (c >> 5), rr = r & 15, cc = c & 31, ob = rr * 64 + cc * 2; return st * 1024 + (ob ^ (((ob >> 9) & 1) << 5)); }
__host__ __device__ __forceinline__ void stage_rc(int b, int& R, int& C) { const int st = b / 1024, sb = b % 1024, swz = sb ^ (((sb >> 9) & 1) << 5); R = (st >> 1) * 16 + swz / 64; C = (st & 1) * 32 + (swz % 64) / 2; }
__host__ __device__ __forceinline__ int perm32(int rho) { const int n = rho >> 4, i = rho & 15; return 8 * (i >> 2) + 4 * n + (i & 3); }

struct Unit { int pm, pn; };
struct Gemm { const bf16_t* A; const bf16_t* Bt; int M, N, K; };

struct StaticOrder {
    int nM, nN, nwg, G, c;
    __host__ __device__ void init(int M, int N, int G_, int c_) { nM = M / BM; nN = N / BM; nwg = nM * nN; G = G_; c = c_; }
    __host__ __device__ bool next(int i, Unit& u) const {
        const long L = (long)i * G + c; if (L >= nwg) return false;
        int wgid = (int)L; { const int q = nwg / NXCD, r = nwg % NXCD, xcd = wgid % NXCD, off = wgid / NXCD; wgid = (xcd < r ? xcd * (q + 1) : r * (q + 1) + (xcd - r) * q) + off; }
        const int nig = WGM * nN, gid = wgid / nig, fm = gid * WGM, gsz = (nM - fm) < WGM ? (nM - fm) : WGM;
        u.pm = fm + ((wgid % nig) % gsz); u.pn = (wgid % nig) / gsz; return true;
    }
    __device__ __forceinline__ void a_ready(const Unit&) const {}
    __device__ __forceinline__ void done(const Unit&) const {}
};

__device__ __forceinline__ unsigned cvt_pk_bf16(float lo, float hi) { unsigned r; asm volatile("v_cvt_pk_bf16_f32 %0, %1, %2" : "=v"(r) : "v"(lo), "v"(hi)); return r; }
typedef float f32x2 __attribute__((ext_vector_type(2)));
__device__ __forceinline__ f32x2 gelu_pk(f32x2 v) {
    const f32x2 av = __builtin_elementwise_abs(v), d = av * 0.2316418882f + 1.0f;
    f32x2 t; t.x = __builtin_amdgcn_rcpf(d.x); t.y = __builtin_amdgcn_rcpf(d.y);
    f32x2 q = t * 0.5307027145f + (-0.7265760135f); q = q * t + 0.7107068705f; q = q * t + (-0.142248368f); q = q * t + 0.127414796f; q = q * t;
    const f32x2 s = (v * v) * (-0.72134752044f);
    f32x2 e; e.x = __builtin_amdgcn_exp2f(s.x); e.y = __builtin_amdgcn_exp2f(s.y);
    const f32x2 m = v * (q * e), r = v - m;
    f32x2 o; o.x = v.x < 0.f ? m.x : r.x; o.y = v.y < 0.f ? m.y : r.y; return o;
}

template <int ACT  > struct EpiBf16 {
    static constexpr bool PERM = true, AFTER_DRAIN = false; static_assert(ACT == 0 || ACT == 1, "EpiBf16: ACT is 0 (none) or 1 (gelu_pk)");
    bf16_t* O; int ldc; const float* bias; int split_cols; size_t split_stride; float scale0;
    __device__ __forceinline__ void operator()(const f32x4 (&acc)[2][2][4][2], const Unit& u, int wr, int wc, int fr, int fq) const {
        const int row0 = u.pm * BM + wr * 64 + fr; int colt = u.pn * BM; bf16_t* base = O;
        float sc = 1.f; if (split_cols) { const int t = colt / split_cols; base += (size_t)t * split_stride; colt -= t * split_cols; if (t == 0) sc = scale0; }
        const int col0 = colt + wc * 32 + 8 * fq, bcol0 = u.pn * BM + wc * 32 + 8 * fq;
        f32x4 bv[2][2];
#pragma unroll
        for (int bj = 0; bj < 2; ++bj)
#pragma unroll
            for (int n = 0; n < 2; ++n) bv[bj][n] = bias ? *(const f32x4*)(bias + bcol0 + bj * HALF + 4 * n) : (f32x4){0.f, 0.f, 0.f, 0.f};
#pragma unroll
        for (int ai = 0; ai < 2; ++ai)
#pragma unroll
            for (int m = 0; m < 4; ++m) { bf16_t* rowp = base + (size_t)(row0 + ai * HALF + m * 16) * ldc + col0;
#pragma unroll
                for (int bj = 0; bj < 2; ++bj) { f32x4 v0 = acc[ai][bj][m][0] + bv[bj][0], v1 = acc[ai][bj][m][1] + bv[bj][1];
                    if (ACT == 1) { f32x2 a = gelu_pk((f32x2){v0[0], v0[1]}), b = gelu_pk((f32x2){v0[2], v0[3]}), c = gelu_pk((f32x2){v1[0], v1[1]}), d = gelu_pk((f32x2){v1[2], v1[3]});
                        v0 = (f32x4){a.x, a.y, b.x, b.y}; v1 = (f32x4){c.x, c.y, d.x, d.y}; }
                    v0 = v0 * sc; v1 = v1 * sc; u32x4 w; w.x = cvt_pk_bf16(v0[0], v0[1]); w.y = cvt_pk_bf16(v0[2], v0[3]); w.z = cvt_pk_bf16(v1[0], v1[1]); w.w = cvt_pk_bf16(v1[2], v1[3]);
                    *(u32x4*)(rowp + bj * HALF) = w; } }
    }
};

typedef unsigned u32x2 __attribute__((ext_vector_type(2)));
struct EpiRowScaleBf16 {
    static constexpr bool PERM = true, AFTER_DRAIN = false;
    bf16_t* O; int ldc; const PG8_LAS float* rs;
    __device__ __forceinline__ void operator()(const f32x4 (&acc)[2][2][4][2], const Unit& u, int wr, int wc, int fr, int fq) const {
        const int col0 = u.pn * BM + wc * 32 + 8 * fq;
#pragma unroll
        for (int ai = 0; ai < 2; ++ai)
#pragma unroll
            for (int m = 0; m < 4; ++m) { const int rl = ai * HALF + wr * 64 + m * 16 + fr; const float s = rs[rl]; bf16_t* rowp = O + (size_t)(u.pm * BM + rl) * ldc + col0;
#pragma unroll
                for (int bj = 0; bj < 2; ++bj) { const f32x4 v0 = acc[ai][bj][m][0] * s, v1 = acc[ai][bj][m][1] * s;
                    u32x4 w; w.x = cvt_pk_bf16(v0[0], v0[1]); w.y = cvt_pk_bf16(v0[2], v0[3]); w.z = cvt_pk_bf16(v1[0], v1[1]); w.w = cvt_pk_bf16(v1[2], v1[3]);
                    *(u32x4*)(rowp + bj * HALF) = w; } }
    }
};
struct EpiResidual {
    static constexpr bool PERM = false, AFTER_DRAIN = false;
    const float* X; float* H; bf16_t* Hb; float* part; int ldc;
    __device__ __forceinline__ void operator()(const f32x4 (&acc)[2][2][4][2], const Unit& u, int wr, int wc, int fr, int fq) const {
        const int col0 = u.pn * BM + wc * 32 + 4 * fq;
#pragma unroll
        for (int ai = 0; ai < 2; ++ai)
#pragma unroll
            for (int m = 0; m < 4; ++m) { const int r = u.pm * BM + ai * HALF + wr * 64 + m * 16 + fr; const size_t off = (size_t)r * ldc + col0; float ss = 0.f;
#pragma unroll
                for (int bj = 0; bj < 2; ++bj)
#pragma unroll
                    for (int n = 0; n < 2; ++n) { const size_t o = off + bj * HALF + n * 16; const f32x4 v = acc[ai][bj][m][n] + *(const f32x4*)(X + o);
                        *(f32x4*)(H + o) = v; u32x2 w; w.x = cvt_pk_bf16(v[0], v[1]); w.y = cvt_pk_bf16(v[2], v[3]); *(u32x2*)(Hb + o) = w;
                        ss += (v[0] * v[0] + v[1] * v[1]) + (v[2] * v[2] + v[3] * v[3]); }
                ss += __shfl_xor(ss, 16); ss += __shfl_xor(ss, 32);
                if (fq == 0) part[(size_t)r * 32 + u.pn * 4 + wc] = ss; }
    }
};
struct EpiGate {
    static constexpr bool PERM = false, AFTER_DRAIN = false;
    const float* H2; const bf16_t* PP; float* OUT; float* part; int ldc; const PG8_LAS float* rs;
    __device__ __forceinline__ void operator()(const f32x4 (&acc)[2][2][4][2], const Unit& u, int wr, int wc, int fr, int fq) const {
        const int col0 = u.pn * BM + wc * 32 + 4 * fq;
#pragma unroll
        for (int ai = 0; ai < 2; ++ai)
#pragma unroll
            for (int m = 0; m < 4; ++m) { const int rl = ai * HALF + wr * 64 + m * 16 + fr, r = u.pm * BM + rl; const float nrs = -rs[rl]; const size_t off = (size_t)r * ldc + col0; float ss = 0.f;
#pragma unroll
                for (int bj = 0; bj < 2; ++bj)
#pragma unroll
                    for (int n = 0; n < 2; ++n) { const size_t o = off + bj * HALF + n * 16; const f32x4 a = acc[ai][bj][m][n]; const f32x4 hv = *(const f32x4*)(H2 + o); const u32x2 pw = *(const u32x2*)(PP + o);
                        f32x4 pp; pp[0] = __uint_as_float(pw.x << 16); pp[1] = __uint_as_float(pw.x & 0xffff0000u); pp[2] = __uint_as_float(pw.y << 16); pp[3] = __uint_as_float(pw.y & 0xffff0000u);
                        f32x4 v;
#pragma unroll
                        for (int i = 0; i < 4; ++i) v[i] = hv[i] + pp[i] / (1.0f + __expf(nrs * a[i]));
                        *(f32x4*)(OUT + o) = v;
                        ss += (v[0] * v[0] + v[1] * v[1]) + (v[2] * v[2] + v[3] * v[3]); }
                ss += __shfl_xor(ss, 16); ss += __shfl_xor(ss, 32);
                if (fq == 0) part[(size_t)r * 32 + u.pn * 4 + wc] = ss; }
    }
};
template <class Epi, class Sched, bool ALIGN_EPI = false, bool SP2 = false>
__device__ __forceinline__ void gemm_phase(PG8_LAS unsigned char* lds, const Gemm g, const Sched& S, const Epi& E) {
    int tid_o = threadIdx.x; asm volatile("" : "+v"(tid_o));
    const int tid = tid_o, wid = __builtin_amdgcn_readfirstlane(tid >> 6), lane = tid & 63, wr = wid >> 2, wc = wid & 3, fr = lane & 15, fq = lane >> 4;
    const int K = g.K, nt = K / BK;
    unsigned voffA[2], voffB[2];
#pragma unroll
    for (int i = 0; i < 2; ++i) { int R, C; stage_rc(tid * 16 + i * 8192, R, C); const int Rb = Epi::PERM ? ((R & ~31) + perm32(R & 31)) : R;
        voffA[i] = (unsigned)(R * K + C) * 2u; voffB[i] = (unsigned)(Rb * K + C) * 2u; }
    const size_t kstep = (size_t)(BK * 2);
    const size_t hstep = (size_t)HALF * K * 2;
    const size_t tstep = 2 * hstep;
    const unsigned ldsw = (unsigned)wid * 1024u;
    const int aoff = lds_byte(wr * 64 + fr, fq * 8), boff = lds_byte(wc * 32 + fr, fq * 8);
#define PG8_SA(b, h) (((b) * 2 + (h)) * HTB)
#define PG8_SB(b, h) ((4 + (b) * 2 + (h)) * HTB)
#define PG8_STAGE(bufoff, gbase, voff) do { _Pragma("unroll") for (int _i = 0; _i < 2; ++_i) \
        __builtin_amdgcn_global_load_lds((const unsigned*)((const char*)(gbase) + (voff)[_i]), (PG8_LAS unsigned*)(lds + (bufoff) + ldsw + _i * 8192), 16, 0, 0); } while (0)
#define PG8_LDA(dst, b, h) do { _Pragma("unroll") for (int m = 0; m < 4; ++m) _Pragma("unroll") for (int k = 0; k < 2; ++k) dst[m][k] = *(const PG8_LAS bf16x8*)(lds + PG8_SA(b, h) + aoff + m * 2048 + k * 1024); } while (0)
#define PG8_LDB(dst, b, h) do { _Pragma("unroll") for (int n = 0; n < 2; ++n) _Pragma("unroll") for (int k = 0; k < 2; ++k) dst[n][k] = *(const PG8_LAS bf16x8*)(lds + PG8_SB(b, h) + boff + n * 2048 + k * 1024); } while (0)
#define PG8_MMA(ai, bj, At, Bt) do { __builtin_amdgcn_s_setprio(1); _Pragma("unroll") for (int m = 0; m < 4; ++m) _Pragma("unroll") for (int n = 0; n < 2; ++n) _Pragma("unroll") for (int k = 0; k < 2; ++k) \
        acc[ai][bj][m][n] = __builtin_amdgcn_mfma_f32_16x16x32_bf16(Bt[n][k], At[m][k], acc[ai][bj][m][n], 0, 0, 0); __builtin_amdgcn_s_setprio(0); } while (0)
#define PG8_WAIT_V(n) asm volatile("s_waitcnt vmcnt(" #n ")" ::: "memory")
#define PG8_WAIT_L(n) asm volatile("s_waitcnt lgkmcnt(" #n ")" ::: "memory")
#define PG8_BAR __builtin_amdgcn_s_barrier()
#define PG8_SCHED __builtin_amdgcn_sched_barrier(0)
    Unit cur, nxt; int ui = 0;
    if (!S.next(0, cur)) return;
    f32x4 acc[2][2][4][2];
#pragma unroll
    for (int a = 0; a < 2; ++a)
#pragma unroll
        for (int b = 0; b < 2; ++b)
#pragma unroll
            for (int m = 0; m < 4; ++m)
#pragma unroll
                for (int n = 0; n < 2; ++n) acc[a][b][m][n] = (f32x4){0.f, 0.f, 0.f, 0.f};
    bf16x8 At[4][2], B0[2][2], B1[2][2];
    const char* cA = (const char*)g.A + (size_t)cur.pm * tstep; const char* cB = (const char*)g.Bt + (size_t)cur.pn * tstep;
    S.a_ready(cur);
    if constexpr (SP2) {
        PG8_STAGE(PG8_SB(0, 0), cB, voffB); PG8_STAGE(PG8_SB(0, 1), cB + hstep, voffB); PG8_STAGE(PG8_SA(0, 0), cA, voffA); PG8_STAGE(PG8_SA(0, 1), cA + hstep, voffA);
        if (wr == 1) PG8_BAR;
        PG8_WAIT_V(2); PG8_BAR;
        PG8_STAGE(PG8_SB(1, 0), cB + kstep, voffB); PG8_STAGE(PG8_SA(1, 0), cA + kstep, voffA); PG8_STAGE(PG8_SB(1, 1), cB + hstep + kstep, voffB);
        PG8_WAIT_V(6); PG8_BAR;
    } else {
        PG8_STAGE(PG8_SB(0, 0), cB, voffB); PG8_STAGE(PG8_SA(0, 0), cA, voffA); PG8_STAGE(PG8_SB(0, 1), cB + hstep, voffB); PG8_STAGE(PG8_SA(0, 1), cA + hstep, voffA);
        if (wr == 1) PG8_BAR;
        PG8_WAIT_V(4); PG8_BAR;
        PG8_STAGE(PG8_SB(1, 0), cB + kstep, voffB); PG8_STAGE(PG8_SA(1, 0), cA + kstep, voffA); PG8_STAGE(PG8_SB(1, 1), cB + hstep + kstep, voffB);
        PG8_WAIT_V(6); PG8_BAR;
    }
    for (;;) {
        const bool has_next = S.next(ui + 1, nxt);
        const char* nA = has_next ? (const char*)g.A + (size_t)nxt.pm * tstep : cA; const char* nB = has_next ? (const char*)g.Bt + (size_t)nxt.pn * tstep : cB;
        for (int t = 0; t < nt; t += 2) {
            const bool last = (t == nt - 2);
            const char* a1 = cA + (size_t)(t + 1) * kstep;
            const char* a2 = last ? nA : cA + (size_t)(t + 2) * kstep; const char* b2 = last ? nB : cB + (size_t)(t + 2) * kstep;
            const char* a3 = a2 + kstep; const char* b3 = b2 + kstep;
            if (last && has_next) S.a_ready(nxt);
            if constexpr (SP2) {
            PG8_LDB(B0, 0, 0); PG8_LDB(B1, 0, 1); PG8_SCHED; PG8_LDA(At, 0, 0); PG8_STAGE(PG8_SA(1, 1), a1 + hstep, voffA);
            PG8_WAIT_V(8); PG8_WAIT_L(0); PG8_BAR; PG8_MMA(0, 0, At, B0); PG8_MMA(0, 1, At, B1); PG8_BAR; PG8_SCHED;
            PG8_LDA(At, 0, 1); PG8_STAGE(PG8_SB(0, 0), b2, voffB); PG8_STAGE(PG8_SB(0, 1), b2 + hstep, voffB); PG8_STAGE(PG8_SA(0, 0), a2, voffA);
            PG8_WAIT_V(8); PG8_WAIT_L(0); PG8_BAR; PG8_MMA(1, 0, At, B0); PG8_MMA(1, 1, At, B1); PG8_BAR; PG8_SCHED;
            PG8_LDB(B0, 1, 0); PG8_LDB(B1, 1, 1); PG8_SCHED; PG8_LDA(At, 1, 0); PG8_STAGE(PG8_SA(0, 1), a2 + hstep, voffA);
            PG8_WAIT_V(8); PG8_WAIT_L(0); PG8_BAR; PG8_MMA(0, 0, At, B0); PG8_MMA(0, 1, At, B1); PG8_BAR; PG8_SCHED;
            PG8_LDA(At, 1, 1); PG8_STAGE(PG8_SB(1, 0), b3, voffB); PG8_STAGE(PG8_SB(1, 1), b3 + hstep, voffB); PG8_STAGE(PG8_SA(1, 0), a3, voffA);
            PG8_WAIT_V(8); PG8_WAIT_L(0); PG8_BAR; PG8_MMA(1, 0, At, B0); PG8_MMA(1, 1, At, B1); PG8_BAR; PG8_SCHED;
            } else {
            PG8_LDB(B0, 0, 0); PG8_SCHED; PG8_LDA(At, 0, 0); PG8_STAGE(PG8_SA(1, 1), a1 + hstep, voffA);
            PG8_WAIT_L(8); PG8_BAR; PG8_WAIT_L(0); PG8_MMA(0, 0, At, B0); PG8_BAR; PG8_SCHED;
            PG8_LDB(B1, 0, 1); PG8_STAGE(PG8_SB(0, 0), b2, voffB);
            PG8_BAR; PG8_WAIT_L(0); PG8_MMA(0, 1, At, B1); PG8_BAR;
            PG8_LDA(At, 0, 1); PG8_STAGE(PG8_SA(0, 0), a2, voffA);
            PG8_BAR; PG8_WAIT_L(0); PG8_MMA(1, 0, At, B0); PG8_BAR; PG8_SCHED;
            PG8_STAGE(PG8_SB(0, 1), b2 + hstep, voffB);
            PG8_WAIT_V(6); PG8_BAR; PG8_MMA(1, 1, At, B1); PG8_BAR;
            PG8_LDB(B0, 1, 0); PG8_SCHED; PG8_LDA(At, 1, 0); PG8_STAGE(PG8_SA(0, 1), a2 + hstep, voffA);
            PG8_WAIT_L(8); PG8_BAR; PG8_WAIT_L(0); PG8_MMA(0, 0, At, B0); PG8_BAR; PG8_SCHED;
            PG8_LDB(B1, 1, 1); PG8_STAGE(PG8_SB(1, 0), b3, voffB);
            PG8_BAR; PG8_WAIT_L(0); PG8_MMA(0, 1, At, B1); PG8_BAR;
            PG8_LDA(At, 1, 1); PG8_STAGE(PG8_SA(1, 0), a3, voffA);
            PG8_BAR; PG8_WAIT_L(0); PG8_MMA(1, 0, At, B0); PG8_BAR; PG8_SCHED;
            PG8_STAGE(PG8_SB(1, 1), b3 + hstep, voffB);
            PG8_WAIT_V(6); PG8_BAR; PG8_MMA(1, 1, At, B1); PG8_BAR;
            }
        }
        if constexpr (ALIGN_EPI) { if (wr == 0) PG8_BAR; }
        if constexpr (!Epi::AFTER_DRAIN) { E(acc, cur, wr, wc, fr, fq); S.done(cur); }
        if (!has_next) break;
#pragma unroll
        for (int a = 0; a < 2; ++a)
#pragma unroll
            for (int b = 0; b < 2; ++b)
#pragma unroll
                for (int m = 0; m < 4; ++m)
#pragma unroll
                    for (int n = 0; n < 2; ++n) acc[a][b][m][n] = (f32x4){0.f, 0.f, 0.f, 0.f};
        cur = nxt; cA = nA; cB = nB; ++ui;
        if constexpr (ALIGN_EPI) { if (wr == 1) PG8_BAR; }
    }
    PG8_WAIT_V(0);
    if constexpr (!ALIGN_EPI) { if (wr == 0) PG8_BAR; }
    PG8_BAR;
    if constexpr (Epi::AFTER_DRAIN) { E.fused(acc, cur, wr, wc, fr, fq, lds, wid, lane); S.done(cur); }
#undef PG8_SA
#undef PG8_SB
#undef PG8_STAGE
#undef PG8_LDA
#undef PG8_LDB
#undef PG8_MMA
#undef PG8_WAIT_V
#undef PG8_WAIT_L
#undef PG8_BAR
#undef PG8_SCHED
}
}

constexpr int NWAVES = 8, NTHR = NWAVES * 64;
constexpr int NT = 8192, DM = 2048, SEQ = 2048, NB = 4;
constexpr int INC = 7176, PROJW = 7168;
constexpr int NEXP = 16384;
constexpr float EPS = 1e-6f;
constexpr size_t MiB = 1u << 20;
constexpr size_t WS_CTL = 0, CTL_ZERO_BYTES = 1 * MiB;
constexpr size_t WS_WIN = 2 * MiB, WS_WOUT = 30 * MiB, WS_WQ = 38 * MiB, WS_WG = 46 * MiB, WS_WP = 54 * MiB, WS_KEYS = 55 * MiB, WS_P16 = 56 * MiB;
constexpr size_t WS_GI = 60 * MiB, WS_BLOC = 61 * MiB, WS_MT = 61 * MiB + 512 * 1024, WS_SCAL = 62 * MiB, WS_LBUF = 62 * MiB + 256 * 1024, WS_NBUF = 62 * MiB + 512 * 1024;
constexpr size_t WS_PART = 63 * MiB, WS_PART2 = 64 * MiB, WS_IDX = 65 * MiB, WS_GW = 69 * MiB, WS_RS2 = 73 * MiB, WS_PART3 = 74 * MiB;
constexpr size_t WS_PA = 240 * MiB;
constexpr size_t WS_U8 = 80 * MiB, WS_V8 = 112 * MiB;
constexpr size_t WS_XN = 208 * MiB;
constexpr size_t WS_PROJ = 240 * MiB, WS_PP = 352 * MiB;
constexpr size_t WS_Y = 384 * MiB;
constexpr size_t WS_UBUF = 416 * MiB;
constexpr size_t WS_END = 480 * MiB;
constexpr int CW_BAR = 4096;
constexpr int LDS_BYTES = 147456;
constexpr int R0_OFF = 0, R1_OFF = 69632, ARR_OFF = 139264, RS_OFF = 145408, MISC_OFF = 146432;

#define GAS __attribute__((address_space(1)))
#define LAS __attribute__((address_space(3)))
typedef unsigned short bf16;
typedef unsigned v4u __attribute__((ext_vector_type(4)));
typedef unsigned v2u __attribute__((ext_vector_type(2)));
typedef float f32x4 __attribute__((ext_vector_type(4)));
typedef short bf16x8 __attribute__((ext_vector_type(8)));
#define LDS_WAIT() asm volatile("s_waitcnt lgkmcnt(0)" ::: "memory")
__device__ __forceinline__ unsigned f2bf(float f) { unsigned u = __builtin_bit_cast(unsigned, f); return (u + 0x7fffu + ((u >> 16) & 1u)) >> 16; }
__device__ __forceinline__ unsigned pk2(float lo, float hi) { return f2bf(lo) | (f2bf(hi) << 16); }
__device__ __forceinline__ float bflo(unsigned w) { return __uint_as_float(w << 16); }
__device__ __forceinline__ float bfhi(unsigned w) { return __uint_as_float(w & 0xffff0000u); }
__device__ __forceinline__ float wave_sum(float v) {
#pragma unroll
    for (int o = 1; o < 64; o <<= 1) v += __shfl_xor(v, o);
    return v;
}

#define XB_TMO      128
#define XB_XCNT(j)  (256  + 64 * (j))
#define XB_XSUB(j)  (1280 + 64 * (j))
#define XB_XGEN(j)  (2304 + 64 * (j))
#define XB_TOP      3328
#define XB_TOPGEN   3392
#define XCD_BAR_WORDS 3456
#define XB_SPIN_CAP (1u << 18)
__device__ __forceinline__ unsigned xb_ld(unsigned* p)              { return __hip_atomic_load(p, __ATOMIC_RELAXED, __HIP_MEMORY_SCOPE_AGENT); }
__device__ __forceinline__ unsigned xb_add(unsigned* p, unsigned v) { return __hip_atomic_fetch_add(p, v, __ATOMIC_RELAXED, __HIP_MEMORY_SCOPE_AGENT); }
__device__ __forceinline__ unsigned xb_xcc_id() { return (unsigned)__builtin_amdgcn_s_getreg((3 << 11) | 20) & 0xFu; }
#define XB_SPIN(cond, bar) do { unsigned _sp = 0; while (cond) { __builtin_amdgcn_s_sleep(1); \
    if ((++_sp & 255u) == 0u) { if (xb_ld(&(bar)[XB_TMO])) break; if (_sp > XB_SPIN_CAP) { atomicAdd(&(bar)[XB_TMO], 1u); break; } } } } while (0)
struct XcdBarrier { unsigned* bar; unsigned x; volatile LAS unsigned* st; };
__device__ __forceinline__ XcdBarrier xcd_barrier_post(unsigned* bar, volatile LAS unsigned* st) {
    XcdBarrier b; b.bar = bar; b.x = xb_xcc_id(); b.st = st;
    if (threadIdx.x == 0) (void)xb_add(&bar[XB_XCNT(b.x)], 1u);
    return b;
}
__device__ __forceinline__ void xcd_barrier_complete(unsigned* bar, unsigned x, unsigned& nloc, unsigned& nx) {
    const unsigned G = gridDim.x * gridDim.y * gridDim.z;
    unsigned sum, cnt, mine, sp = 0u;
    for (;;) {
        sum = 0u; cnt = 0u; mine = 0u;
#pragma unroll
        for (unsigned j = 0; j < 16; ++j) { const unsigned c = xb_ld(&bar[XB_XCNT(j)]); sum += c; cnt += (c > 0u) ? 1u : 0u; mine = (j == x) ? c : mine; }
        if (sum == G) break;
        __builtin_amdgcn_s_sleep(1);
        if ((++sp & 255u) == 0u) { if (xb_ld(&bar[XB_TMO])) break; if (sp > XB_SPIN_CAP) { atomicAdd(&bar[XB_TMO], 1u); break; } }
    }
    nloc = mine > 0u ? mine : 1u; nx = cnt > 0u ? cnt : 1u;
}
__device__ __forceinline__ void xcd_barrier(const XcdBarrier& b) {
    asm volatile("s_waitcnt vmcnt(0)" ::: "memory");
    __syncthreads();
    if (threadIdx.x == 0) {
        unsigned* bar = b.bar;
        __builtin_amdgcn_s_waitcnt(0);
        unsigned nloc = b.st[0], nx = b.st[1];
        if (nloc == 0u) { xcd_barrier_complete(bar, b.x, nloc, nx); b.st[0] = nloc; b.st[1] = nx; }
        const unsigned old = xb_add(&bar[XB_XSUB(b.x)], 1u);
        const unsigned gen = old / nloc;
        if (old + 1u == (gen + 1u) * nloc) {
            __builtin_amdgcn_fence(__ATOMIC_RELEASE, "agent");
            asm volatile("s_waitcnt vmcnt(0)" ::: "memory");
            const unsigned og = xb_add(&bar[XB_TOP], 1u);
            const unsigned tg = og / nx;
            if (og + 1u == (tg + 1u) * nx) xb_add(&bar[XB_TOPGEN], 1u);
            else XB_SPIN(xb_ld(&bar[XB_TOPGEN]) == tg, bar);
            __builtin_amdgcn_fence(__ATOMIC_ACQUIRE, "agent");
            xb_add(&bar[XB_XGEN(b.x)], 1u);
            asm volatile("s_waitcnt vmcnt(0)" ::: "memory");
        } else {
            XB_SPIN(xb_ld(&bar[XB_XGEN(b.x)]) == gen, bar);
            __builtin_amdgcn_fence(__ATOMIC_ACQUIRE, "agent");
            asm volatile("s_waitcnt vmcnt(0)" ::: "memory");
        }
    }
    __syncthreads();
}

struct Args { const float* in[17]; float* out; unsigned char* ws; unsigned long long pad; };

__device__ __forceinline__ void p0_transpose_item(const float* W, int ldw, int K, bf16* WT, int nblk, int item, LAS float* scr, int lane, const float* kscale) {
    const int kb = item / nblk, nb = item % nblk, k0 = 64 * kb, n0 = 32 * nb;
#pragma unroll 8
    for (int i = 0; i < 32; ++i) { const int kk = 2 * i + (lane >> 5); float v = W[(size_t)(k0 + kk) * ldw + n0 + (lane & 31)]; if (kscale) v *= kscale[k0 + kk]; scr[kk * 33 + (lane & 31)] = v; }
    LDS_WAIT(); asm volatile("" ::: "memory");
    const int c = lane & 7;
#pragma unroll
    for (int j = 0; j < 4; ++j) { const int n = (lane >> 3) + 8 * j; const LAS float* s = scr + (8 * c) * 33 + n;
        v4u o; o.x = pk2(s[0 * 33], s[1 * 33]); o.y = pk2(s[2 * 33], s[3 * 33]); o.z = pk2(s[4 * 33], s[5 * 33]); o.w = pk2(s[6 * 33], s[7 * 33]);
        *(GAS v4u*)(WT + (size_t)(n0 + n) * K + k0 + 8 * c) = o; }
    LDS_WAIT(); asm volatile("" ::: "memory");
}
__device__ __forceinline__ void cvt_stream(const float* src, bf16* dst, size_t n8, size_t gtid, size_t nthr) {
    for (size_t i = gtid; i < n8; i += nthr) { const f32x4 a = ((const GAS f32x4*)src)[2 * i], b = ((const GAS f32x4*)src)[2 * i + 1];
        v4u o; o.x = pk2(a.x, a.y); o.y = pk2(a.z, a.w); o.z = pk2(b.x, b.y); o.w = pk2(b.z, b.w); ((GAS v4u*)dst)[i] = o; }
}
__device__ __forceinline__ void cvt_stream_fp8(const float* src, unsigned char* dst, size_t n16, size_t gtid, size_t nthr) {
#pragma unroll 2
    for (size_t i = gtid; i < n16; i += nthr) { const GAS f32x4* s = (const GAS f32x4*)src + 4 * i; v4u o;
#pragma unroll
        for (int q = 0; q < 4; ++q) { const f32x4 a = s[q] * 256.0f; int w = 0; w = __builtin_amdgcn_cvt_pk_fp8_f32(a.x, a.y, w, false); w = __builtin_amdgcn_cvt_pk_fp8_f32(a.z, a.w, w, true); o[q] = (unsigned)w; }
        ((GAS v4u*)dst)[i] = o; }
}
__device__ __forceinline__ float log_sigmoid(float x) { return fminf(x, 0.f) - log1pf(expf(-fabsf(x))); }

__device__ __forceinline__ void phase0(const Args& A, LAS unsigned char* lds, int tid, int lane, int wave) {
    unsigned char* ws = A.ws;
    const int G = gridDim.x, gw = blockIdx.x * NWAVES + wave, NGW = G * NWAVES;
    const size_t gtid = (size_t)blockIdx.x * NTHR + tid, nthr = (size_t)G * NTHR;
    {
        LAS float* scr = (LAS float*)(lds + wave * 16384);
        constexpr int I_IN = 32 * 224, I_SQ = 32 * 64, I_P = 4 * 64;
        constexpr int NITEMS = I_IN + 3 * I_SQ + I_P;
        for (int it = gw; it < NITEMS; it += NGW) {
            int r = it;
            if (r < I_IN) { p0_transpose_item(A.in[3], INC, DM, (bf16*)(ws + WS_WIN), 224, r, scr, lane, nullptr); continue; } r -= I_IN;
            if (r < I_SQ) { p0_transpose_item(A.in[7], DM, DM, (bf16*)(ws + WS_WOUT), 64, r, scr, lane, nullptr); continue; } r -= I_SQ;
            if (r < I_SQ) { p0_transpose_item(A.in[9], DM, DM, (bf16*)(ws + WS_WQ), 64, r, scr, lane, A.in[8]); continue; } r -= I_SQ;
            if (r < I_SQ) { p0_transpose_item(A.in[14], DM, DM, (bf16*)(ws + WS_WG), 64, r, scr, lane, A.in[13]); continue; } r -= I_SQ;
            p0_transpose_item(A.in[15], DM, 256, (bf16*)(ws + WS_WP), 64, r, scr, lane, nullptr);
        }
    }
    cvt_stream(A.in[10], (bf16*)(ws + WS_KEYS), (size_t)8 * 2 * 128 * 128 / 8, gtid, nthr);
    cvt_stream(A.in[1], (bf16*)(ws + WS_P16), (size_t)NT * 256 / 8, gtid, nthr);
    cvt_stream_fp8(A.in[11], ws + WS_U8, (size_t)NEXP * DM / 16, gtid, nthr);
    cvt_stream_fp8(A.in[12], ws + WS_V8, (size_t)NEXP * DM / 16, gtid, nthr);
    __syncthreads();
    LAS float* wg8 = (LAS float*)lds;
    for (int i = tid; i < DM * 8; i += NTHR) wg8[i] = A.in[3][(size_t)(i >> 3) * INC + PROJW + (i & 7)];
    __syncthreads();
    {
        const float* x = A.in[0]; const float* g = A.in[2]; const float* gb = A.in[5];
        bf16* XN = (bf16*)(ws + WS_XN); float* GI = (float*)(ws + WS_GI);
        f32x4 gv[8];
#pragma unroll
        for (int j = 0; j < 8; ++j) gv[j] = ((const GAS f32x4*)g)[lane + 64 * j];
        for (int t = gw; t < NT; t += NGW) {
            const GAS f32x4* xr = (const GAS f32x4*)(x + (size_t)t * DM) + lane;
            f32x4 v[8]; float ss = 0.f;
#pragma unroll
            for (int j = 0; j < 8; ++j) { v[j] = xr[64 * j]; ss += (v[j].x * v[j].x + v[j].y * v[j].y) + (v[j].z * v[j].z + v[j].w * v[j].w); }
            const float rstd = 1.0f / sqrtf(wave_sum(ss) * (1.0f / DM) + EPS);
            float ga[8];
#pragma unroll
            for (int c = 0; c < 8; ++c) ga[c] = 0.f;
            GAS v2u* o8 = (GAS v2u*)(XN + (size_t)t * DM) + lane;
#pragma unroll
            for (int j = 0; j < 8; ++j) {
                f32x4 xn = v[j] * rstd * gv[j];
                v2u o; o.x = pk2(xn.x, xn.y); o.y = pk2(xn.z, xn.w); o8[64 * j] = o;
#pragma unroll
                for (int i = 0; i < 4; ++i) { const int e = 4 * lane + 256 * j + i; const f32x4 w0 = *(const LAS f32x4*)(wg8 + e * 8), w1 = *(const LAS f32x4*)(wg8 + e * 8 + 4); const float xv = xn[i];
                    ga[0] += xv * w0.x; ga[1] += xv * w0.y; ga[2] += xv * w0.z; ga[3] += xv * w0.w; ga[4] += xv * w1.x; ga[5] += xv * w1.y; ga[6] += xv * w1.z; ga[7] += xv * w1.w; }
                asm volatile("" ::: "memory");
            }
            float outv = 0.f;
#pragma unroll
            for (int c = 0; c < 8; ++c) { const float s = wave_sum(ga[c]); if (lane == c) outv = s; }
            if (lane < 8) { float val = outv + gb[lane]; if (lane >= 4) val = log_sigmoid(val); GI[(size_t)t * 8 + lane] = val; }
        }
    }
}

constexpr int TRS = 272;
constexpr int NRS = 528;
constexpr int A_BL = 0, A_PML = 16, A_BS = 32, A_IS = 160, A_PMS = 288, A_WV = 416, A_MT = 544, A_NL = 672;

__device__ __forceinline__ void phase_x1(const Args& A, LAS unsigned char* lds, int tid, int lane, int wave) {
    unsigned char* ws = A.ws;
    const float* GI = (const float*)(ws + WS_GI); const bf16* PROJ = (const bf16*)(ws + WS_PROJ);
    float* BLOC = (float*)(ws + WS_BLOC); float* MT = (float*)(ws + WS_MT); float* SCAL = (float*)(ws + WS_SCAL); float* LBUF = (float*)(ws + WS_LBUF); float* UBUF = (float*)(ws + WS_UBUF);
    LAS float* arr = (LAS float*)(lds + ARR_OFF);
    const int lm = lane & 15, g = lane >> 4;
    for (int u = blockIdx.x; u < 256; u += gridDim.x) {
        const int c = u & 15, h = (u >> 4) & 3, b = u >> 6;
        const int t0 = b * SEQ + c * 128;
        __syncthreads();
#pragma unroll
        for (int rep = 0; rep < 2; ++rep) {
            const int cc = wave + 8 * rep;
            if (cc <= c) {
                const size_t tt = (size_t)(b * SEQ + cc * 128 + 2 * lane);
                const float i0 = GI[tt * 8 + h], i1 = GI[(tt + 1) * 8 + h], lf0 = GI[tt * 8 + 4 + h], lf1 = GI[(tt + 1) * 8 + 4 + h];
                const float p = lf0 + lf1; float incl = p;
#pragma unroll
                for (int o = 1; o < 64; o <<= 1) { const float y = __shfl_up(incl, o); if (lane >= o) incl += y; }
                const float excl = incl - p, b0 = excl + lf0, b1 = incl;
                const float g0 = i0 - b0, g1 = i1 - b1, q = fmaxf(g0, g1); float im = q;
#pragma unroll
                for (int o = 1; o < 64; o <<= 1) { const float y = __shfl_up(im, o); if (lane >= o) im = fmaxf(im, y); }
                float em = __shfl_up(im, 1); if (lane == 0) em = -INFINITY;
                if (lane == 63) { arr[A_BL + cc] = incl; arr[A_PML + cc] = im; }
                if (cc == c) { arr[A_BS + 2 * lane] = b0; arr[A_BS + 2 * lane + 1] = b1; arr[A_IS + 2 * lane] = i0; arr[A_IS + 2 * lane + 1] = i1;
                    arr[A_PMS + 2 * lane] = fmaxf(em, g0); arr[A_PMS + 2 * lane + 1] = im; }
            }
        }
        __syncthreads();
        float mprev = 0.f;
        for (int cc = 0; cc < c; ++cc) mprev = arr[A_BL + cc] + fmaxf(mprev, arr[A_PML + cc]);
        const float blast = arr[A_BL + c];
        const float mnew = arr[A_BS + 127] + fmaxf(mprev, arr[A_PMS + 127]);
        if (tid < 128) {
            const float bt = arr[A_BS + tid], mt = bt + fmaxf(mprev, arr[A_PMS + tid]);
            arr[A_WV + tid] = expf(blast - bt + arr[A_IS + tid] - mnew) * 0.0625f;
            BLOC[(size_t)(t0 + tid) * 4 + h] = bt; MT[(size_t)(t0 + tid) * 4 + h] = mt;
        }
        if (tid == 0) { SCAL[u * 4 + 0] = expf(blast + mprev - mnew); SCAL[u * 4 + 1] = mprev; }
        __syncthreads();
#pragma unroll
        for (int it = 0; it < 4; ++it) {
            const int d0 = (wave * 4 + it) * 8;
            const bf16* r0p = PROJ + (size_t)(t0 + 2 * lane) * PROJW + h * 256 + d0;
            const v4u k0 = *(const GAS v4u*)(r0p + 4096), k1 = *(const GAS v4u*)(r0p + 4096 + PROJW);
            const v4u v0 = *(const GAS v4u*)(r0p + 5120), v1 = *(const GAS v4u*)(r0p + 5120 + PROJW);
            const float w0 = arr[A_WV + 2 * lane], w1 = arr[A_WV + 2 * lane + 1];
#pragma unroll
            for (int j = 0; j < 4; ++j) {
                const unsigned ka = k0[j], kb = k1[j], va = v0[j], vb = v1[j];
                *(LAS unsigned*)(lds + R0_OFF + (d0 + 2 * j) * TRS + 4 * lane) = (ka & 0xffffu) | (kb << 16);
                *(LAS unsigned*)(lds + R0_OFF + (d0 + 2 * j + 1) * TRS + 4 * lane) = (ka >> 16) | (kb & 0xffff0000u);
                *(LAS unsigned*)(lds + R1_OFF + (d0 + 2 * j) * TRS + 4 * lane) = pk2(bflo(va) * w0, bflo(vb) * w1);
                *(LAS unsigned*)(lds + R1_OFF + (d0 + 2 * j + 1) * TRS + 4 * lane) = pk2(bfhi(va) * w0, bfhi(vb) * w1);
            }
        }
        __syncthreads();
        if (tid < 256) {
            float s = 0.f;
#pragma unroll 4
            for (int s8 = 0; s8 < 16; ++s8) { const v4u kv = *(const LAS v4u*)(lds + R0_OFF + tid * TRS + s8 * 16);
#pragma unroll
                for (int j = 0; j < 4; ++j) s += bflo(kv[j]) * arr[A_WV + s8 * 8 + 2 * j] + bfhi(kv[j]) * arr[A_WV + s8 * 8 + 2 * j + 1]; }
            LBUF[u * 256 + tid] = s;
        }
        float* Uo = UBUF + (size_t)u * 65536;
#pragma unroll 1
        for (int dh = 0; dh < 2; ++dh) {
            f32x4 acc[2][8];
#pragma unroll
            for (int i = 0; i < 2; ++i)
#pragma unroll
                for (int j = 0; j < 8; ++j) acc[i][j] = (f32x4){0.f, 0.f, 0.f, 0.f};
#pragma unroll
            for (int kk = 0; kk < 4; ++kk) {
                bf16x8 af[2];
#pragma unroll
                for (int i = 0; i < 2; ++i) af[i] = *(const LAS bf16x8*)(lds + R1_OFF + (32 * wave + 16 * i + lm) * TRS + (32 * kk + 8 * g) * 2);
#pragma unroll
                for (int j = 0; j < 8; ++j) { const bf16x8 bfr = *(const LAS bf16x8*)(lds + R0_OFF + (128 * dh + 16 * j + lm) * TRS + (32 * kk + 8 * g) * 2);
#pragma unroll
                    for (int i = 0; i < 2; ++i) acc[i][j] = __builtin_amdgcn_mfma_f32_16x16x32_bf16(af[i], bfr, acc[i][j], 0, 0, 0); }
            }
#pragma unroll
            for (int i = 0; i < 2; ++i)
#pragma unroll
                for (int j = 0; j < 8; ++j)
#pragma unroll
                    for (int r = 0; r < 4; ++r) Uo[(size_t)(32 * wave + 16 * i + 4 * g + r) * 256 + 128 * dh + 16 * j + lm] = acc[i][j][r];
        }
    }
}

__device__ __forceinline__ void phase_x2(const Args& A, int tid) {
    unsigned char* ws = A.ws;
    const float* SCAL = (const float*)(ws + WS_SCAL); const float* LBUF = (const float*)(ws + WS_LBUF); const float* UBUF = (const float*)(ws + WS_UBUF);
    float* NBUF = (float*)(ws + WS_NBUF); bf16* CT = (bf16*)(ws + WS_XN);
    const bf16* PROJ = (const bf16*)(ws + WS_PROJ); bf16* Y = (bf16*)(ws + WS_Y);
    const size_t gtid = (size_t)blockIdx.x * NTHR + tid, nthr = (size_t)gridDim.x * NTHR;
    for (size_t it = gtid; it < (size_t)16 * 16384; it += nthr) {
        const int bh = (int)(it >> 14), r = (int)(it & 16383);
        f32x4 C = (f32x4){0.f, 0.f, 0.f, 0.f};
#pragma unroll 5
        for (int c = 0; c < 15; ++c) { const int u = bh * 16 + c; const float a = SCAL[u * 4];
            const f32x4 uv = *(const GAS f32x4*)(UBUF + (size_t)u * 65536 + (size_t)r * 4); C = C * a + uv;
            v2u o; o.x = pk2(C.x, C.y); o.y = pk2(C.z, C.w); *(GAS v2u*)(CT + (size_t)(u + 1) * 65536 + (size_t)r * 4) = o; }
    }
    for (size_t it = gtid; it < 4096; it += nthr) {
        const int bh = (int)(it >> 8), d = (int)(it & 255); float n = 0.f;
        for (int c = 0; c < 15; ++c) { const int u = bh * 16 + c; n = n * SCAL[u * 4] + LBUF[u * 256 + d]; NBUF[(u + 1) * 256 + d] = n; }
    }
    const float* cw = A.in[4];
    for (size_t it = gtid; it < (size_t)NT * 128; it += nthr) {
        const int t = (int)(it >> 7), c0 = (int)(it & 127) * 8, s = t & (SEQ - 1);
        const bf16* row = PROJ + (size_t)t * PROJW + c0;
        const v4u bc = *(const GAS v4u*)row, cc0 = *(const GAS v4u*)(row + 1024), uc0 = *(const GAS v4u*)(row + 2048);
        v4u cc1 = (v4u){0, 0, 0, 0}, uc1 = cc1, cc2 = cc1, uc2 = cc1;
        if (s >= 1) { cc1 = *(const GAS v4u*)(row - PROJW + 1024); uc1 = *(const GAS v4u*)(row - PROJW + 2048); }
        if (s >= 2) { cc2 = *(const GAS v4u*)(row - 2 * PROJW + 1024); uc2 = *(const GAS v4u*)(row - 2 * PROJW + 2048); }
        float w0[8], w1[8], w2[8];
#pragma unroll
        for (int i = 0; i < 8; ++i) { w0[i] = cw[c0 + i]; w1[i] = cw[1024 + c0 + i]; w2[i] = cw[2048 + c0 + i]; }
        v4u o;
#pragma unroll
        for (int j = 0; j < 4; ++j) {
            const float ylo = bflo(bc[j]) * (w0[2 * j] * (bflo(cc2[j]) * bflo(uc2[j])) + w1[2 * j] * (bflo(cc1[j]) * bflo(uc1[j])) + w2[2 * j] * (bflo(cc0[j]) * bflo(uc0[j])));
            const float yhi = bfhi(bc[j]) * (w0[2 * j + 1] * (bfhi(cc2[j]) * bfhi(uc2[j])) + w1[2 * j + 1] * (bfhi(cc1[j]) * bfhi(uc1[j])) + w2[2 * j + 1] * (bfhi(cc0[j]) * bfhi(uc0[j])));
            o[j] = pk2(ylo, yhi);
        }
        *(GAS v4u*)(Y + (size_t)t * DM + c0) = o;
    }
}

__device__ __forceinline__ void phase_x3(const Args& A, LAS unsigned char* lds, int tid, int lane, int wave) {
    unsigned char* ws = A.ws;
    const float* GI = (const float*)(ws + WS_GI); const bf16* PROJ = (const bf16*)(ws + WS_PROJ);
    const float* BLOC = (const float*)(ws + WS_BLOC); const float* MT = (const float*)(ws + WS_MT); const float* SCAL = (const float*)(ws + WS_SCAL); const float* NBUF = (const float*)(ws + WS_NBUF);
    const bf16* CT = (const bf16*)(ws + WS_XN); bf16* Y = (bf16*)(ws + WS_Y);
    const float* gm = A.in[6];
    LAS float* arr = (LAS float*)(lds + ARR_OFF);
    const int lm = lane & 15, g = lane >> 4;
    for (int u = blockIdx.x; u < 256; u += gridDim.x) {
        const int c = u & 15, h = (u >> 4) & 3, b = u >> 6;
        const int t0 = b * SEQ + c * 128;
        const float mprev = SCAL[u * 4 + 1];
        __syncthreads();
        if (tid < 128) { arr[A_BS + tid] = BLOC[(size_t)(t0 + tid) * 4 + h]; arr[A_MT + tid] = MT[(size_t)(t0 + tid) * 4 + h]; arr[A_IS + tid] = GI[(size_t)(t0 + tid) * 8 + h]; }
        if (tid < 256) arr[A_NL + tid] = (c > 0) ? NBUF[u * 256 + tid] : 0.f;
        const bf16* qp = PROJ + (size_t)(t0 + 16 * wave + lm) * PROJW + 3072 + h * 256 + 8 * g;
        float qn = 0.f;
        f32x4 acc[16];
#pragma unroll
        for (int j = 0; j < 16; ++j) acc[j] = (f32x4){0.f, 0.f, 0.f, 0.f};
        if (c > 0) {
            const bf16* ct = CT + (size_t)u * 65536;
#pragma unroll 4
            for (int i = 0; i < 16; ++i) { const int q = tid + NTHR * i, e = q >> 5, ch = q & 31;
                const v4u v = *(const GAS v4u*)(ct + (size_t)e * 256 + ch * 8);
                *(LAS v4u*)(lds + (e < 128 ? R0_OFF + e * NRS : R1_OFF + (e - 128) * NRS) + ch * 16) = v; }
            __syncthreads();
            bf16x8 qa = *(const GAS bf16x8*)qp;
#pragma unroll
            for (int kk = 0; kk < 8; ++kk) {
                const bf16x8 qnx = *(const GAS bf16x8*)(qp + 32 * (kk < 7 ? kk + 1 : 7));
#pragma unroll
                for (int j = 0; j < 16; ++j) { const bf16x8 bfr = *(const LAS bf16x8*)(lds + (j < 8 ? R0_OFF : R1_OFF) + (16 * (j & 7) + lm) * NRS + (32 * kk + 8 * g) * 2);
                    acc[j] = __builtin_amdgcn_mfma_f32_16x16x32_bf16(qa, bfr, acc[j], 0, 0, 0); }
#pragma unroll
                for (int jj = 0; jj < 8; ++jj) qn += __uint_as_float(((unsigned)(unsigned short)qa[jj]) << 16) * arr[A_NL + 32 * kk + 8 * g + jj];
                asm volatile("" ::: "memory");
                qa = qnx;
            }
        } else { __syncthreads(); }
        float at[4];
#pragma unroll
        for (int r = 0; r < 4; ++r) { const int t = 16 * wave + 4 * g + r; at[r] = expf(arr[A_BS + t] + mprev - arr[A_MT + t]); }
        qn += __shfl_xor(qn, 16); qn += __shfl_xor(qn, 32);
#pragma unroll
        for (int j = 0; j < 16; ++j)
#pragma unroll
            for (int r = 0; r < 4; ++r) acc[j][r] *= at[r];
        __syncthreads();
        {
#pragma unroll
            for (int i = 0; i < 8; ++i) { const int q = tid + NTHR * i, s = q >> 5, ch = q & 31;
                const v4u v = *(const GAS v4u*)(PROJ + (size_t)(t0 + s) * PROJW + 4096 + h * 256 + ch * 8);
                *(LAS v4u*)(lds + R0_OFF + s * NRS + ch * 16) = v; }
#pragma unroll
            for (int it = 0; it < 4; ++it) {
                const int d0 = (wave * 4 + it) * 8;
                const bf16* r0p = PROJ + (size_t)(t0 + 2 * lane) * PROJW + 5120 + h * 256 + d0;
                const v4u v0 = *(const GAS v4u*)r0p, v1 = *(const GAS v4u*)(r0p + PROJW);
#pragma unroll
                for (int j = 0; j < 4; ++j) {
                    const unsigned va = v0[j], vb = v1[j];
                    *(LAS unsigned*)(lds + R1_OFF + (d0 + 2 * j) * TRS + 4 * lane) = (va & 0xffffu) | (vb << 16);
                    *(LAS unsigned*)(lds + R1_OFF + (d0 + 2 * j + 1) * TRS + 4 * lane) = (va >> 16) | (vb & 0xffff0000u);
                }
            }
        }
        __syncthreads();
        f32x4 sacc[8];
#pragma unroll
        for (int j = 0; j < 8; ++j) sacc[j] = (f32x4){0.f, 0.f, 0.f, 0.f};
        {
            bf16x8 qa = *(const GAS bf16x8*)qp;
#pragma unroll
            for (int kk = 0; kk < 8; ++kk) {
                const bf16x8 qnx = *(const GAS bf16x8*)(qp + 32 * (kk < 7 ? kk + 1 : 7));
#pragma unroll
                for (int j = 0; j < 8; ++j) { const bf16x8 bfr = *(const LAS bf16x8*)(lds + R0_OFF + (16 * j + lm) * NRS + (32 * kk + 8 * g) * 2);
                    sacc[j] = __builtin_amdgcn_mfma_f32_16x16x32_bf16(qa, bfr, sacc[j], 0, 0, 0); }
                asm volatile("" ::: "memory");
                qa = qnx;
            }
        }
        float rb[4], mtr[4], dsum[4];
#pragma unroll
        for (int r = 0; r < 4; ++r) { const int t = 16 * wave + 4 * g + r; mtr[r] = arr[A_MT + t]; rb[r] = arr[A_BS + t] - mtr[r]; dsum[r] = 0.f; }
#pragma unroll
        for (int j = 0; j < 8; ++j) { const int s = 16 * j + lm; const float cb = arr[A_IS + s] - arr[A_BS + s];
#pragma unroll
            for (int r = 0; r < 4; ++r) { const int t = 16 * wave + 4 * g + r; const float p = (s <= t) ? sacc[j][r] * 0.0625f * __expf(rb[r] + cb) : 0.f; sacc[j][r] = p; dsum[r] += p; } }
#pragma unroll
        for (int r = 0; r < 4; ++r) { float d = dsum[r]; d += __shfl_xor(d, 1); d += __shfl_xor(d, 2); d += __shfl_xor(d, 4); d += __shfl_xor(d, 8); dsum[r] = d; }
        __syncthreads();
#pragma unroll
        for (int j = 0; j < 8; ++j)
#pragma unroll
            for (int r = 0; r < 4; ++r) *(LAS unsigned short*)(lds + R0_OFF + (16 * wave + 4 * g + r) * TRS + (16 * j + lm) * 2) = (unsigned short)f2bf(sacc[j][r]);
        __syncthreads();
#pragma unroll
        for (int kk = 0; kk < 4; ++kk) {
            const bf16x8 pa = *(const LAS bf16x8*)(lds + R0_OFF + (16 * wave + lm) * TRS + (32 * kk + 8 * g) * 2);
#pragma unroll
            for (int j = 0; j < 16; ++j) { const bf16x8 vb = *(const LAS bf16x8*)(lds + R1_OFF + (16 * j + lm) * TRS + (32 * kk + 8 * g) * 2);
                acc[j] = __builtin_amdgcn_mfma_f32_16x16x32_bf16(pa, vb, acc[j], 0, 0, 0); }
            asm volatile("" ::: "memory");
        }
        float ssq[4], inv[4];
#pragma unroll
        for (int r = 0; r < 4; ++r) { const float qnr = __shfl(qn, 4 * g + r); const float den = at[r] * qnr + dsum[r]; inv[r] = 1.0f / fmaxf(fabsf(den), expf(-mtr[r])); ssq[r] = 0.f; }
#pragma unroll
        for (int j = 0; j < 16; ++j)
#pragma unroll
            for (int r = 0; r < 4; ++r) { const float hv = acc[j][r] * inv[r]; acc[j][r] = hv; ssq[r] += hv * hv; }
#pragma unroll
        for (int r = 0; r < 4; ++r) { float d = ssq[r]; d += __shfl_xor(d, 1); d += __shfl_xor(d, 2); d += __shfl_xor(d, 4); d += __shfl_xor(d, 8); ssq[r] = 1.0f / sqrtf(d * (1.0f / 256.0f) + EPS); }
#pragma unroll
        for (int j = 0; j < 16; ++j) { const int e = 16 * j + lm; const float gmv = gm[h * 256 + e];
#pragma unroll
            for (int r = 0; r < 4; ++r) { const size_t tg = (size_t)(t0 + 16 * wave + 4 * g + r);
                const float o = __uint_as_float(((unsigned)PROJ[tg * PROJW + 6144 + h * 256 + e]) << 16);
                const float yv = (acc[j][r] * ssq[r] * gmv) / (1.0f + __expf(-o));
                Y[tg * DM + 1024 + h * 256 + e] = (bf16)f2bf(yv); }
            asm volatile("" ::: "memory"); }
    }
}

__device__ __forceinline__ unsigned fkey(float v) { const unsigned u = __float_as_uint(v); return (u & 0x80000000u) ? ~u : (u | 0x80000000u); }
__device__ __forceinline__ float fdec(unsigned k) { return __uint_as_float((k & 0x80000000u) ? (k & 0x7fffffffu) : ~k); }
#define TK_CE(a, b) do { const unsigned _t = max((a), (b)); (b) = min((a), (b)); (a) = _t; } while (0)
template <int BASE> __device__ __forceinline__ void tk_sort16(unsigned (&v)[64]) {
#pragma unroll
    for (int k = 2; k <= 16; k <<= 1)
#pragma unroll
        for (int j = k >> 1; j > 0; j >>= 1)
#pragma unroll
            for (int i = 0; i < 16; ++i) { const int l = i ^ j; if (l > i) { if ((i & k) == 0) TK_CE(v[BASE + i], v[BASE + l]); else TK_CE(v[BASE + l], v[BASE + i]); } }
}
template <int A0, int B0> __device__ __forceinline__ void tk_merge16(unsigned (&v)[64]) {
#pragma unroll
    for (int i = 0; i < 16; ++i) v[A0 + i] = max(v[A0 + i], v[B0 + 15 - i]);
#pragma unroll
    for (int j = 8; j > 0; j >>= 1)
#pragma unroll
        for (int i = 0; i < 16; ++i) { const int l = i ^ j; if (l > i) TK_CE(v[A0 + i], v[A0 + l]); }
}

__device__ __forceinline__ void phase5(const Args& A, LAS unsigned char* lds, int tid, int lane, int wave) {
    unsigned char* ws = A.ws;
    const bf16* QP = (const bf16*)(ws + WS_Y); const bf16* KEYS = (const bf16*)(ws + WS_KEYS);
    int* IDX = (int*)(ws + WS_IDX); float* GW = (float*)(ws + WS_GW);
    LAS float* SC = (LAS float*)lds;
    LAS unsigned* LST = (LAS unsigned*)lds;
    const int lm = lane & 15, g = lane >> 4;
    for (int u = blockIdx.x; u < 512; u += gridDim.x) {
        const int tt = u >> 3, h = u & 7;
        __syncthreads();
#pragma unroll 1
        for (int p = 0; p < 2; ++p) {
            f32x4 sacc[8];
#pragma unroll
            for (int j = 0; j < 8; ++j) sacc[j] = (f32x4){0.f, 0.f, 0.f, 0.f};
            const bf16* qp = QP + (size_t)(tt * 128 + 16 * wave + lm) * DM + h * 256 + p * 128 + 8 * g;
            const bf16* kp = KEYS + (size_t)((h * 2 + p) * 128 + lm) * 128 + 8 * g;
#pragma unroll
            for (int kk = 0; kk < 4; ++kk) { const bf16x8 af = *(const GAS bf16x8*)(qp + 32 * kk);
#pragma unroll
                for (int j = 0; j < 8; ++j) { const bf16x8 bfr = *(const GAS bf16x8*)(kp + (size_t)(16 * j) * 128 + 32 * kk);
                    sacc[j] = __builtin_amdgcn_mfma_f32_16x16x32_bf16(af, bfr, sacc[j], 0, 0, 0); } }
#pragma unroll
            for (int j = 0; j < 8; ++j)
#pragma unroll
                for (int r = 0; r < 4; ++r) SC[(p * 128 + 16 * wave + 4 * g + r) * 129 + 16 * j + lm] = sacc[j][r];
        }
        __syncthreads();
        unsigned v[64];
        {
            const int t = (tid >> 1) & 127, half = tid & 1, p = tid >> 8;
            const LAS float* row = SC + (p * 128 + t) * 129;
#pragma unroll
            for (int i = 0; i < 64; ++i) { const int n = 64 * half + ((i + 16 * half) & 63); v[i] = (fkey(row[n]) & ~127u) | (unsigned)(127 - n); }
            tk_sort16<0>(v); tk_sort16<16>(v); tk_sort16<32>(v); tk_sort16<48>(v);
            tk_merge16<0, 16>(v); tk_merge16<32, 48>(v); tk_merge16<0, 32>(v);
#pragma unroll
            for (int j = 0; j < 16; ++j) v[16 + j] = __shfl_xor(v[j], 1);
            tk_merge16<0, 16>(v);
        }
        __syncthreads();
        if ((tid & 1) == 0) { const int t = (tid >> 1) & 127, p = tid >> 8;
#pragma unroll
            for (int j = 0; j < 4; ++j) *(LAS v4u*)(LST + (p * 128 + t) * 16 + 4 * j) = (v4u){v[4 * j], v[4 * j + 1], v[4 * j + 2], v[4 * j + 3]}; }
        __syncthreads();
        {
            const int t = tid >> 2, sub = tid & 3;
            const unsigned long long d0 = sub == 0 ? 0x0706050403020100ull : sub == 1 ? 0x1716151413121110ull : sub == 2 ? 0x5042414033323130ull : 0xf0e0d0c0b0a09080ull;
            const unsigned long long d1 = sub == 0 ? 0x0f0e0d0c0b0a0908ull : sub == 1 ? 0xffffff2423222120ull : sub == 2 ? 0xffffff7170616051ull : 0xffffffffffffffffull;
#pragma unroll
            for (int s = 0; s < 16; ++s) {
                const unsigned ij = (unsigned)((s < 8 ? d0 >> (8 * s) : d1 >> (8 * (s - 8))) & 0xffu);
                const unsigned i = ij >> 4, j = ij & 15u;
                const float sum = fdec(LST[t * 16 + i] & ~127u) + fdec(LST[(128 + t) * 16 + j] & ~127u);
                v[s] = (fkey(sum) & ~255u) | (255u - ij);
            }
            tk_sort16<0>(v);
#pragma unroll
            for (int j = 0; j < 16; ++j) v[16 + j] = __shfl_xor(v[j], 1);
            tk_merge16<0, 16>(v);
#pragma unroll
            for (int j = 0; j < 16; ++j) v[16 + j] = __shfl_xor(v[j], 2);
            tk_merge16<0, 16>(v);
            if (sub == 0) {
                float bs[16]; int ex[16];
#pragma unroll
                for (int k = 0; k < 16; ++k) { const unsigned pos = 255u - (v[k] & 255u), i = pos >> 4, j = pos & 15u;
                    const unsigned k0 = LST[t * 16 + i], k1 = LST[(128 + t) * 16 + j];
                    bs[k] = fdec(k0 & ~127u) + fdec(k1 & ~127u); ex[k] = (127 - (int)(k0 & 127u)) * 128 + (127 - (int)(k1 & 127u)); }
                float mx = bs[0];
#pragma unroll
                for (int k = 1; k < 16; ++k) mx = fmaxf(mx, bs[k]);
                float sum = 0.f;
#pragma unroll
                for (int k = 0; k < 16; ++k) { bs[k] = expf(bs[k] - mx); sum += bs[k]; }
                const float rs = 1.0f / sum;
                const size_t o = ((size_t)(tt * 128 + t) * 8 + h) * 16;
#pragma unroll
                for (int k = 0; k < 4; ++k) { *(GAS v4u*)(IDX + o + 4 * k) = (v4u){(unsigned)ex[4 * k], (unsigned)ex[4 * k + 1], (unsigned)ex[4 * k + 2], (unsigned)ex[4 * k + 3]};
                    *(GAS f32x4*)(GW + o + 4 * k) = (f32x4){bs[4 * k] * rs, bs[4 * k + 1] * rs, bs[4 * k + 2] * rs, bs[4 * k + 3] * rs}; }
            }
        }
    }
}

__device__ __forceinline__ float gelu_erf(float a) { return 0.5f * a * (1.0f + erff(a * 0.70710678118654752f)); }
typedef float f32x2 __attribute__((ext_vector_type(2)));
__device__ __forceinline__ void p6_dot16(const v4u w, const f32x2 (&x)[8], float& p) {
    f32x2 acc = (f32x2){0.f, 0.f};
#pragma unroll
    for (int d = 0; d < 4; ++d) { const int wd = (int)w[d];
        acc = __builtin_elementwise_fma(__builtin_amdgcn_cvt_pk_f32_fp8(wd, false), x[2 * d], acc);
        acc = __builtin_elementwise_fma(__builtin_amdgcn_cvt_pk_f32_fp8(wd, true), x[2 * d + 1], acc); }
    p = acc.x + acc.y;
}
template <int step> __device__ __forceinline__ void phase6ac(const Args& A, int lane, int wave) {
    unsigned char* ws = A.ws;
    const int* IDX = (const int*)(ws + WS_IDX); const float* W = (const float*)(ws + WS_GW);
#ifdef DBG_TAB_H
    const unsigned char* TAB = ws + WS_UBUF;
#else
    const unsigned char* TAB = ws + (step ? WS_V8 : WS_U8);
#endif
    const float* H = (const float*)(ws + WS_UBUF); const float* RS2 = (const float*)(ws + WS_RS2); float* PA = (float*)(ws + WS_PA);
    float* H2 = (float*)(ws + WS_PA); bf16* H2b = (bf16*)(ws + WS_XN); float* PART3 = (float*)(ws + WS_PART3);
    const float* gf = A.in[8];
    const int xg = blockIdx.x & 7, wi = blockIdx.x >> 3, q = lane >> 3, c = lane & 7;
    const bool c2 = c & 4, c1 = c & 2, c0 = c & 1, q2 = q & 4, q1 = q & 2, q0 = q & 1;
#pragma unroll 1
    for (int pass = 0; pass < 2; ++pass) {
        const int s = xg + 8 * pass, col0 = 128 * s + 16 * c;
        v4u ev[4];
        { const GAS v4u* ip = (const GAS v4u*)(IDX + (size_t)(256 * wi + wave) * 128 + 16 * q);
#pragma unroll
          for (int j = 0; j < 4; ++j) ev[j] = ip[j]; }
#pragma unroll 1
        for (int i = 0; i < 32; ++i) {
            const int t = 256 * wi + wave + 8 * i;
            v4u w[16];
#pragma unroll
#ifdef DBG_ROW0
            for (int ii = 0; ii < 16; ++ii) w[ii] = *(const GAS v4u*)(TAB + (size_t)(ev[ii >> 2][ii & 3] & 1u) * DM + col0);
#elif !defined(DBG_NO_TAB)
            for (int ii = 0; ii < 16; ++ii) { const unsigned off = ((ev[ii >> 2][ii & 3] & 16383u) << 11) + (unsigned)col0; w[ii] = *(const GAS v4u*)(TAB + off); }
#else
            for (int ii = 0; ii < 16; ++ii) { const unsigned e = ev[ii >> 2][ii & 3]; w[ii] = (v4u){e, e + 1u, e + 2u, e + 3u}; }
#endif
            { const int tn = 256 * wi + wave + 8 * (i < 31 ? i + 1 : 31); const GAS v4u* ip = (const GAS v4u*)(IDX + (size_t)tn * 128 + 16 * q);
#pragma unroll
              for (int j = 0; j < 4; ++j) ev[j] = ip[j]; }
            if (step == 0) {
                const float rs = RS2[t] * (1.0f / 256.0f);
                f32x2 x[8];
                { const GAS f32x4* hr = (const GAS f32x4*)(H + (size_t)t * DM + col0); const GAS f32x4* gq = (const GAS f32x4*)(gf + col0);
#pragma unroll
                  for (int j = 0; j < 4; ++j) { const f32x4 xv = hr[j] * rs * gq[j]; x[2 * j] = (f32x2){xv.x, xv.y}; x[2 * j + 1] = (f32x2){xv.z, xv.w}; } }
                float p[16];
#ifdef DBG_NO_DOT
#pragma unroll
                for (int ii = 0; ii < 16; ++ii) p[ii] = __uint_as_float((w[ii].x ^ w[ii].y ^ w[ii].z ^ w[ii].w) & 0x3fffffffu) + x[ii & 7].x;
#else
#pragma unroll
                for (int ii = 0; ii < 16; ++ii) p6_dot16(w[ii], x, p[ii]);
#endif
                float r8[8], r4[4], r2[2];
#ifdef DBG_NO_BFLY
                r2[0] = 0.f; r2[1] = 0.f;
#pragma unroll
                for (int j = 0; j < 16; ++j) { r2[j & 1] += p[j]; }
                if (0) { r8[0] = r4[0] = 0.f; }
#else
#pragma unroll
                for (int j = 0; j < 8; ++j) { const float snd = c2 ? p[j] : p[j + 8], kp = c2 ? p[j + 8] : p[j]; r8[j] = kp + __shfl_xor(snd, 4); }
#pragma unroll
                for (int j = 0; j < 4; ++j) { const float snd = c1 ? r8[j] : r8[j + 4], kp = c1 ? r8[j + 4] : r8[j]; r4[j] = kp + __shfl_xor(snd, 2); }
#pragma unroll
                for (int j = 0; j < 2; ++j) { const float snd = c0 ? r4[j] : r4[j + 2], kp = c0 ? r4[j + 2] : r4[j]; r2[j] = kp + __shfl_xor(snd, 1); }
#endif
#ifndef DBG_NO_PA_ST
                *(GAS f32x2*)(PA + (size_t)s * ((size_t)NT * 128) + (size_t)t * 128 + 16 * q + 2 * c) = (f32x2){r2[0], r2[1]};
#else
                if (r2[0] == 1234.5f && r2[1] == 77.f) PA[0] = 1.f;
#endif
            } else {
                const f32x2 hv = *(const GAS f32x2*)(H + (size_t)t * DM + col0 + 2 * q);
                f32x4 wv[4];
                { const GAS f32x4* wp = (const GAS f32x4*)(W + (size_t)t * 128 + 16 * q);
#pragma unroll
                  for (int j = 0; j < 4; ++j) wv[j] = wp[j]; }
                f32x2 o[8];
#pragma unroll
                for (int j = 0; j < 8; ++j) o[j] = (f32x2){0.f, 0.f};
#pragma unroll
                for (int ii = 0; ii < 16; ++ii) { const float wkk = wv[ii >> 2][ii & 3]; const f32x2 wk2 = (f32x2){wkk, wkk};
#pragma unroll
                    for (int d = 0; d < 4; ++d) { const int wd = (int)w[ii][d];
                        o[2 * d] = __builtin_elementwise_fma(__builtin_amdgcn_cvt_pk_f32_fp8(wd, false), wk2, o[2 * d]);
                        o[2 * d + 1] = __builtin_elementwise_fma(__builtin_amdgcn_cvt_pk_f32_fp8(wd, true), wk2, o[2 * d + 1]); } }
                f32x2 r4[4], r2[2], r1;
#pragma unroll
                for (int j = 0; j < 4; ++j) { const f32x2 snd = q2 ? o[j] : o[j + 4], kp = q2 ? o[j + 4] : o[j]; r4[j].x = kp.x + __shfl_xor(snd.x, 32); r4[j].y = kp.y + __shfl_xor(snd.y, 32); }
#pragma unroll
                for (int j = 0; j < 2; ++j) { const f32x2 snd = q1 ? r4[j] : r4[j + 2], kp = q1 ? r4[j + 2] : r4[j]; r2[j].x = kp.x + __shfl_xor(snd.x, 16); r2[j].y = kp.y + __shfl_xor(snd.y, 16); }
                { const f32x2 snd = q0 ? r2[0] : r2[1], kp = q0 ? r2[1] : r2[0]; r1.x = kp.x + __shfl_xor(snd.x, 8); r1.y = kp.y + __shfl_xor(snd.y, 8); }
                const f32x2 h2 = hv + r1;
                *(GAS f32x2*)(H2 + (size_t)t * DM + col0 + 2 * q) = h2;
                *(GAS unsigned*)(H2b + (size_t)t * DM + col0 + 2 * q) = pk2(h2.x, h2.y);
                const float ss = wave_sum(h2.x * h2.x + h2.y * h2.y);
                if (lane == 0) PART3[(size_t)t * 16 + s] = ss;
            }
        }
    }
}
__device__ __forceinline__ void phase6b(const Args& A, int tid) {
    unsigned char* ws = A.ws;
    const float* PA = (const float*)(ws + WS_PA); float* GW = (float*)(ws + WS_GW);
    const size_t gtid = (size_t)blockIdx.x * NTHR + tid, nthr = (size_t)gridDim.x * NTHR;
    for (size_t i = gtid; i < (size_t)NT * 128 / 4; i += nthr) {
        f32x4 a = (f32x4){0.f, 0.f, 0.f, 0.f};
#pragma unroll
        for (int s = 0; s < 16; ++s) a += ((const GAS f32x4*)(PA + (size_t)s * ((size_t)NT * 128)))[i];
        const f32x4 gv = ((const GAS f32x4*)GW)[i];
        f32x4 o; o.x = gelu_erf(a.x) * gv.x; o.y = gelu_erf(a.y) * gv.y; o.z = gelu_erf(a.z) * gv.z; o.w = gelu_erf(a.w) * gv.w;
        ((GAS f32x4*)GW)[i] = o * (1.0f / 256.0f);
    }
}
__device__ __forceinline__ void phase8(const Args& A, int lane, int wave) {
    const float* PART2 = (const float*)(A.ws + WS_PART2); const float* gfin = A.in[16]; float* out = A.out;
    const int gw = blockIdx.x * NWAVES + wave, NGW = gridDim.x * NWAVES;
    for (int t = gw; t < NT; t += NGW) {
        float ps = PART2[(size_t)t * 32 + (lane & 31)];
        ps += __shfl_xor(ps, 1); ps += __shfl_xor(ps, 2); ps += __shfl_xor(ps, 4); ps += __shfl_xor(ps, 8); ps += __shfl_xor(ps, 16);
        const float rstd = 1.0f / sqrtf(ps * (1.0f / DM) + EPS);
        GAS f32x4* r = (GAS f32x4*)(out + (size_t)t * DM) + lane; const GAS f32x4* gr = (const GAS f32x4*)gfin + lane;
#pragma unroll
        for (int j = 0; j < 8; ++j) r[64 * j] = r[64 * j] * rstd * gr[64 * j];
    }
}

__global__ void __launch_bounds__(NTHR, 2) mk_fwd(Args args) {
    extern __shared__ __attribute__((aligned(16))) unsigned char lds_raw[];
    LAS unsigned char* lds = (LAS unsigned char*)lds_raw;
    int tid = threadIdx.x, lane = tid & 63, wave = __builtin_amdgcn_readfirstlane(tid >> 6);
#define FRESH_TID() do { tid = threadIdx.x; asm volatile("" : "+v"(tid)); lane = tid & 63; wave = __builtin_amdgcn_readfirstlane(tid >> 6); { const __attribute__((address_space(4))) Args* kp_ = (const __attribute__((address_space(4))) Args*)__builtin_amdgcn_kernarg_segment_ptr(); asm volatile("" : "+s"(kp_)); __builtin_memcpy(&pa, (const void*)kp_, sizeof(Args)); ws = pa.ws; } } while (0)
    volatile LAS unsigned* MISC = (volatile LAS unsigned*)(lds + MISC_OFF);
    if (tid < 32) MISC[tid] = 0u;
    __syncthreads();
    unsigned char* ws = args.ws; Args pa = args;
    XcdBarrier bar = xcd_barrier_post((unsigned*)(ws + WS_CTL) + CW_BAR, MISC + 8);
    const int G = gridDim.x, bx = blockIdx.x;

#ifndef NO_P0
    FRESH_TID(); phase0(pa, lds, tid, lane, wave);
#endif
    xcd_barrier(bar);
#if defined(STOP_AFTER) && STOP_AFTER == 1
    return;
#endif

#ifdef DUP_P0
    FRESH_TID(); phase0(pa, lds, tid, lane, wave);
    xcd_barrier(bar);
#if defined(STOP_AFTER) && STOP_AFTER == 2
    return;
#endif

#endif
#ifdef DUP_P1
#define NREP_P1 2
#else
#define NREP_P1 1
#endif
#pragma unroll 1
    for (int rep1 = 0; rep1 < NREP_P1; ++rep1) { FRESH_TID();
        pg8::Gemm g{(const bf16*)(ws + WS_XN), (const bf16*)(ws + WS_WIN), NT, PROJW, DM}; pg8::StaticOrder S; S.init(NT, PROJW, G, bx);
        pg8::EpiBf16<0> E{(bf16*)(ws + WS_PROJ), PROJW, nullptr, 0, 0, 1.f};
        pg8::gemm_phase<pg8::EpiBf16<0>, pg8::StaticOrder, true, true>(lds, g, S, E);
        pg8::Gemm g2{(const bf16*)(ws + WS_P16), (const bf16*)(ws + WS_WP), NT, DM, 256}; pg8::StaticOrder S2; S2.init(NT, DM, G, bx);
        pg8::EpiBf16<0> E2{(bf16*)(ws + WS_PP), DM, nullptr, 0, 0, 1.f};
        pg8::gemm_phase<pg8::EpiBf16<0>, pg8::StaticOrder, true, true>(lds, g2, S2, E2);
    }
    xcd_barrier(bar);
#if defined(STOP_AFTER) && STOP_AFTER == 3
    return;
#endif

#ifdef DUP_X
#define NREP_X 2
#else
#define NREP_X 1
#endif
#pragma unroll 1
    for (int rep = 0; rep < NREP_X; ++rep) {
#ifndef NO_X1
    FRESH_TID(); phase_x1(pa, lds, tid, lane, wave);
#endif
    xcd_barrier(bar);
#if defined(STOP_AFTER) && STOP_AFTER == 4
    return;
#endif

#ifndef NO_X2
    FRESH_TID(); phase_x2(pa, tid);
#endif
    xcd_barrier(bar);
#if defined(STOP_AFTER) && STOP_AFTER == 5
    return;
#endif

#ifndef NO_X3
    FRESH_TID(); phase_x3(pa, lds, tid, lane, wave);
#endif
    xcd_barrier(bar);
#if defined(STOP_AFTER) && STOP_AFTER == 6
    return;
#endif

    }
    { FRESH_TID();
        pg8::Gemm g{(const bf16*)(ws + WS_Y), (const bf16*)(ws + WS_WOUT), NT, DM, DM}; pg8::StaticOrder S; S.init(NT, DM, G, bx);
        pg8::EpiResidual E{args.in[0], (float*)(ws + WS_UBUF), (bf16*)(ws + WS_XN), (float*)(ws + WS_PART), DM};
        pg8::gemm_phase<pg8::EpiResidual, pg8::StaticOrder, true, true>(lds, g, S, E);
    }
    xcd_barrier(bar);
#if defined(STOP_AFTER) && STOP_AFTER == 7
    return;
#endif

    { FRESH_TID();
        pg8::Gemm g{(const bf16*)(ws + WS_XN), (const bf16*)(ws + WS_WQ), NT, DM, DM}; pg8::StaticOrder S; S.init(NT, DM, G, bx);
        LAS float* rs = (LAS float*)(lds + RS_OFF);
        pg8::Unit u0; FRESH_TID();
        if (S.next(0, u0)) {
            const float* PART = (const float*)(ws + WS_PART);
            const int row = tid >> 1, hf = tid & 1; const float* pr = PART + (size_t)(u0.pm * 256 + row) * 32 + hf * 16; float s = 0.f;
#pragma unroll
            for (int i = 0; i < 4; ++i) { const f32x4 v = *(const GAS f32x4*)(pr + 4 * i); s += (v.x + v.y) + (v.z + v.w); }
            s += __shfl_xor(s, 1);
            if (hf == 0) { const float r = 1.0f / sqrtf(s * (1.0f / DM) + EPS); rs[row] = r; if (u0.pn == 0) ((float*)(ws + WS_RS2))[u0.pm * 256 + row] = r; }
        }
        __syncthreads();
        pg8::EpiRowScaleBf16 E{(bf16*)(ws + WS_Y), DM, (const PG8_LAS float*)rs};
        pg8::gemm_phase<pg8::EpiRowScaleBf16, pg8::StaticOrder, true, true>(lds, g, S, E);
    }
    xcd_barrier(bar);
#if defined(STOP_AFTER) && STOP_AFTER == 8
    return;
#endif

#ifndef NO_P5
    FRESH_TID(); phase5(pa, lds, tid, lane, wave);
#endif
    xcd_barrier(bar);
#if defined(STOP_AFTER) && STOP_AFTER == 9
    return;
#endif

#ifdef DUP_P5
    FRESH_TID(); phase5(pa, lds, tid, lane, wave);
    xcd_barrier(bar);
#if defined(STOP_AFTER) && STOP_AFTER == 10
    return;
#endif

#endif
    FRESH_TID(); phase6ac<0>(pa, lane, wave);
    xcd_barrier(bar);
#if defined(STOP_AFTER) && STOP_AFTER == 11
    return;
#endif

    FRESH_TID(); phase6b(pa, tid);
    xcd_barrier(bar);
#if defined(STOP_AFTER) && STOP_AFTER == 12
    return;
#endif

    FRESH_TID(); phase6ac<1>(pa, lane, wave);
    xcd_barrier(bar);
#if defined(STOP_AFTER) && STOP_AFTER == 13
    return;
#endif

    { FRESH_TID();
        pg8::Gemm g{(const bf16*)(ws + WS_XN), (const bf16*)(ws + WS_WG), NT, DM, DM}; pg8::StaticOrder S; S.init(NT, DM, G, bx);
        LAS float* rs = (LAS float*)(lds + RS_OFF);
        pg8::Unit u0; FRESH_TID();
        if (S.next(0, u0)) {
            const float* PART3 = (const float*)(ws + WS_PART3);
            const int row = tid >> 1, hf = tid & 1; const float* pr = PART3 + (size_t)(u0.pm * 256 + row) * 16 + hf * 8; float s = 0.f;
#pragma unroll
            for (int i = 0; i < 2; ++i) { const f32x4 v = *(const GAS f32x4*)(pr + 4 * i); s += (v.x + v.y) + (v.z + v.w); }
            s += __shfl_xor(s, 1);
            if (hf == 0) rs[row] = 1.0f / sqrtf(s * (1.0f / DM) + EPS);
        }
        __syncthreads();
#ifdef DBG_H1
        pg8::EpiGate E{(const float*)(ws + WS_UBUF), (const bf16*)(ws + WS_PP), args.out,
#else
        pg8::EpiGate E{(const float*)(ws + WS_PA), (const bf16*)(ws + WS_PP), args.out,
#endif
            (float*)(ws + WS_PART2), DM, (const PG8_LAS float*)rs};
        pg8::gemm_phase<pg8::EpiGate, pg8::StaticOrder, true, true>(lds, g, S, E);
    }
    xcd_barrier(bar);
#if defined(STOP_AFTER) && STOP_AFTER == 14
    return;
#endif

#ifndef NO_P8
    FRESH_TID(); phase8(pa, lane, wave);
#endif
}

extern "C" void kernel_launch(void* const* d_in, const int* in_sizes, int n_in, void* d_out, int out_size, void* d_ws, size_t ws_size, hipStream_t stream) {
    static int grid = 0;
    if (grid == 0) {
        if (n_in != 17 || out_size != NT * DM || ws_size < WS_END) { fprintf(stderr, "kernel_launch: unexpected shapes (n_in %d, out %d, ws %zu); nothing launched\n", n_in, out_size, ws_size); grid = -1; return; }
        int dev = 0, cus = 0, per_cu = 0;
        if (hipGetDevice(&dev) != hipSuccess || hipDeviceGetAttribute(&cus, hipDeviceAttributeMultiprocessorCount, dev) != hipSuccess) { grid = -1; return; }
        if (hipFuncSetAttribute((const void*)mk_fwd, hipFuncAttributeMaxDynamicSharedMemorySize, LDS_BYTES) != hipSuccess) { fprintf(stderr, "kernel_launch: hipFuncSetAttribute failed\n"); grid = -1; return; }
        if (hipOccupancyMaxActiveBlocksPerMultiprocessor(&per_cu, (const void*)mk_fwd, NTHR, LDS_BYTES) != hipSuccess || per_cu < 1) { fprintf(stderr, "kernel_launch: occupancy query says %d blocks per CU\n", per_cu); }
        (void)hipGetLastError();
        grid = cus;
    }
    if (grid < 0) return;
    (void)hipMemsetAsync((char*)d_ws + WS_CTL, 0, CTL_ZERO_BYTES, stream);
    Args a{};
    for (int i = 0; i < 17; ++i) a.in[i] = (const float*)d_in[i];
    a.out = (float*)d_out; a.ws = (unsigned char*)d_ws; a.pad = 0ull;
    hipLaunchKernelGGL(mk_fwd, dim3(grid), dim3(NTHR), LDS_BYTES, stream, a);
}
```

```cpp
#include <hip/hip_runtime.h>
#include <cstdio>
#include <cstdint>
#include <cmath>
namespace pg8 {
#define PG8_LAS __attribute__((address_space(3)))
typedef unsigned short bf16_t;
typedef short bf16x8 __attribute__((ext_vector_type(8)));
typedef float f32x4 __attribute__((ext_vector_type(4)));
typedef unsigned u32x4 __attribute__((ext_vector_type(4)));
constexpr int BM = 256, BK = 64, HALF = 128, HTB = HALF * BK * 2  , STAGE_BYTES = 8 * HTB, NXCD = 8, WGM = 8;

__host__ __device__ __forceinline__ int lds_byte(int r, int c) { const int st = (r >> 4) * 2 + (c >> 5), rr = r & 15, cc = c & 31, ob = rr * 64 + cc * 2; return st * 1024 + (ob ^ (((ob >> 9) & 1) << 5)); }
__host__ __device__ __forceinline__ void stage_rc(int b, int& R, int& C) { const int st = b / 1024, sb = b % 1024, swz = sb ^ (((sb >> 9) & 1) << 5); R = (st >> 1) * 16 + swz / 64; C = (st & 1) * 32 + (swz % 64) / 2; }
__host__ __device__ __forceinline__ int perm32(int rho) { const int n = rho >> 4, i = rho & 15; return 8 * (i >> 2) + 4 * n + (i & 3); }

struct Unit { int pm, pn; };
struct Gemm { const bf16_t* A; const bf16_t* Bt; int M, N, K; };

struct StaticOrder {
    int nM, nN, nwg, G, c;
    __host__ __device__ void init(int M, int N, int G_, int c_) { nM = M / BM; nN = N / BM; nwg = nM * nN; G = G_; c = c_; }
    __host__ __device__ bool next(int i, Unit& u) const {
        const long L = (long)i * G + c; if (L >= nwg) return false;
        int wgid = (int)L; { const int q = nwg / NXCD, r = nwg % NXCD, xcd = wgid % NXCD, off = wgid / NXCD; wgid = (xcd < r ? xcd * (q + 1) : r * (q + 1) + (xcd - r) * q) + off; }
        const int nig = WGM * nN, gid = wgid / nig, fm = gid * WGM, gsz = (nM - fm) < WGM ? (nM - fm) : WGM;
        u.pm = fm + ((wgid % nig) % gsz); u.pn = (wgid % nig) / gsz; return true;
    }
    __device__ __forceinline__ void a_ready(const Unit&) const {}
    __device__ __forceinline__ void done(const Unit&) const {}
};

__device__ __forceinline__ unsigned cvt_pk_bf16(float lo, float hi) { unsigned r; asm volatile("v_cvt_pk_bf16_f32 %0, %1, %2" : "=v"(r) : "v"(lo), "v"(hi)); return r; }
typedef float f32x2 __attribute__((ext_vector_type(2)));
__device__ __forceinline__ f32x2 gelu_pk(f32x2 v) {
    const f32x2 av = __builtin_elementwise_abs(v), d = av * 0.2316418882f + 1.0f;
    f32x2 t; t.x = __builtin_amdgcn_rcpf(d.x); t.y = __builtin_amdgcn_rcpf(d.y);
    f32x2 q = t * 0.5307027145f + (-0.7265760135f); q = q * t + 0.7107068705f; q = q * t + (-0.142248368f); q = q * t + 0.127414796f; q = q * t;
    const f32x2 s = (v * v) * (-0.72134752044f);
    f32x2 e; e.x = __builtin_amdgcn_exp2f(s.x); e.y = __builtin_amdgcn_exp2f(s.y);
    const f32x2 m = v * (q * e), r = v - m;
    f32x2 o; o.x = v.x < 0.f ? m.x : r.x; o.y = v.y < 0.f ? m.y : r.y; return o;
}

template <int ACT  > struct EpiBf16 {
    static constexpr bool PERM = true, AFTER_DRAIN = false; static_assert(ACT == 0 || ACT == 1, "EpiBf16: ACT is 0 (none) or 1 (gelu_pk)");
    bf16_t* O; int ldc; const float* bias; int split_cols; size_t split_stride; float scale0;
    __device__ __forceinline__ void operator()(const f32x4 (&acc)[2][2][4][2], const Unit& u, int wr, int wc, int fr, int fq) const {
        const int row0 = u.pm * BM + wr * 64 + fr; int colt = u.pn * BM; bf16_t* base = O;
        float sc = 1.f; if (split_cols) { const int t = colt / split_cols; base += (size_t)t * split_stride; colt -= t * split_cols; if (t == 0) sc = scale0; }
        const int col0 = colt + wc * 32 + 8 * fq, bcol0 = u.pn * BM + wc * 32 + 8 * fq;
        f32x4 bv[2][2];
#pragma unroll
        for (int bj = 0; bj < 2; ++bj)
#pragma unroll
            for (int n = 0; n < 2; ++n) bv[bj][n] = bias ? *(const f32x4*)(bias + bcol0 + bj * HALF + 4 * n) : (f32x4){0.f, 0.f, 0.f, 0.f};
#pragma unroll
        for (int ai = 0; ai < 2; ++ai)
#pragma unroll
            for (int m = 0; m < 4; ++m) { bf16_t* rowp = base + (size_t)(row0 + ai * HALF + m * 16) * ldc + col0;
#pragma unroll
                for (int bj = 0; bj < 2; ++bj) { f32x4 v0 = acc[ai][bj][m][0] + bv[bj][0], v1 = acc[ai][bj][m][1] + bv[bj][1];
                    if (ACT == 1) { f32x2 a = gelu_pk((f32x2){v0[0], v0[1]}), b = gelu_pk((f32x2){v0[2], v0[3]}), c = gelu_pk((f32x2){v1[0], v1[1]}), d = gelu_pk((f32x2){v1[2], v1[3]});
                        v0 = (f32x4){a.x, a.y, b.x, b.y}; v1 = (f32x4){c.x, c.y, d.x, d.y}; }
                    v0 = v0 * sc; v1 = v1 * sc; u32x4 w; w.x = cvt_pk_bf16(v0[0], v0[1]); w.y = cvt_pk_bf16(v0[2], v0[3]); w.z = cvt_pk_bf16(v1[0], v1[1]); w.w = cvt_pk_bf16(v1[2], v1[3]);
                    *(u32x4*)(rowp + bj * HALF) = w; } }
    }
};

typedef unsigned u32x2 __attribute__((ext_vector_type(2)));
struct EpiRowScaleBf16 {
    static constexpr bool PERM = true, AFTER_DRAIN = false;
    bf16_t* O; int ldc; const PG8_LAS float* rs;
    __device__ __forceinline__ void operator()(const f32x4 (&acc)[2][2][4][2], const Unit& u, int wr, int wc, int fr, int fq) const {
        const int col0 = u.pn * BM + wc * 32 + 8 * fq;
#pragma unroll
        for (int ai = 0; ai < 2; ++ai)
#pragma unroll
            for (int m = 0; m < 4; ++m) { const int rl = ai * HALF + wr * 64 + m * 16 + fr; const float s = rs[rl]; bf16_t* rowp = O + (size_t)(u.pm * BM + rl) * ldc + col0;
#pragma unroll
                for (int bj = 0; bj < 2; ++bj) { const f32x4 v0 = acc[ai][bj][m][0] * s, v1 = acc[ai][bj][m][1] * s;
                    u32x4 w; w.x = cvt_pk_bf16(v0[0], v0[1]); w.y = cvt_pk_bf16(v0[2], v0[3]); w.z = cvt_pk_bf16(v1[0], v1[1]); w.w = cvt_pk_bf16(v1[2], v1[3]);
                    *(u32x4*)(rowp + bj * HALF) = w; } }
    }
};
struct EpiResidual {
    static constexpr bool PERM = false, AFTER_DRAIN = false;
    const float* X; float* H; bf16_t* Hb; float* part; int ldc;
    __device__ __forceinline__ void operator()(const f32x4 (&acc)[2][2][4][2], const Unit& u, int wr, int wc, int fr, int fq) const {
        const int col0 = u.pn * BM + wc * 32 + 4 * fq;
#pragma unroll
        for (int ai = 0; ai < 2; ++ai)
#pragma unroll
            for (int m = 0; m < 4; ++m) { const int r = u.pm * BM + ai * HALF + wr * 64 + m * 16 + fr; const size_t off = (size_t)r * ldc + col0; float ss = 0.f;
#pragma unroll
                for (int bj = 0; bj < 2; ++bj)
#pragma unroll
                    for (int n = 0; n < 2; ++n) { const size_t o = off + bj * HALF + n * 16; const f32x4 v = acc[ai][bj][m][n] + *(const f32x4*)(X + o);
                        *(f32x4*)(H + o) = v; u32x2 w; w.x = cvt_pk_bf16(v[0], v[1]); w.y = cvt_pk_bf16(v[2], v[3]); *(u32x2*)(Hb + o) = w;
                        ss += (v[0] * v[0] + v[1] * v[1]) + (v[2] * v[2] + v[3] * v[3]); }
                ss += __shfl_xor(ss, 16); ss += __shfl_xor(ss, 32);
                if (fq == 0) part[(size_t)r * 32 + u.pn * 4 + wc] = ss; }
    }
};
struct EpiGate {
    static constexpr bool PERM = false, AFTER_DRAIN = false;
    const float* H2; const bf16_t* PP; float* OUT; float* part; int ldc; const PG8_LAS float* rs;
    __device__ __forceinline__ void operator()(const f32x4 (&acc)[2][2][4][2], const Unit& u, int wr, int wc, int fr, int fq) const {
        const int col0 = u.pn * BM + wc * 32 + 4 * fq;
#pragma unroll
        for (int ai = 0; ai < 2; ++ai)
#pragma unroll
            for (int m = 0; m < 4; ++m) { const int rl = ai * HALF + wr * 64 + m * 16 + fr, r = u.pm * BM + rl; const float nrs = -rs[rl]; const size_t off = (size_t)r * ldc + col0; float ss = 0.f;
#pragma unroll
                for (int bj = 0; bj < 2; ++bj)
#pragma unroll
                    for (int n = 0; n < 2; ++n) { const size_t o = off + bj * HALF + n * 16; const f32x4 a = acc[ai][bj][m][n]; const f32x4 hv = *(const f32x4*)(H2 + o); const u32x2 pw = *(const u32x2*)(PP + o);
                        f32x4 pp; pp[0] = __uint_as_float(pw.x << 16); pp[1] = __uint_as_float(pw.x & 0xffff0000u); pp[2] = __uint_as_float(pw.y << 16); pp[3] = __uint_as_float(pw.y & 0xffff0000u);
                        f32x4 v;
#pragma unroll
                        for (int i = 0; i < 4; ++i) v[i] = hv[i] + pp[i] / (1.0f + __expf(nrs * a[i]));
                        *(f32x4*)(OUT + o) = v;
                        ss += (v[0] * v[0] + v[1] * v[1]) + (v[2] * v[2] + v[3] * v[3]); }
                ss += __shfl_xor(ss, 16); ss += __shfl_xor(ss, 32);
                if (fq == 0) part[(size_t)r * 32 + u.pn * 4 + wc] = ss; }
    }
};
template <class Epi, class Sched, bool ALIGN_EPI = false, bool SP2 = false>
__device__ __forceinline__ void gemm_phase(PG8_LAS unsigned char* lds, const Gemm g, const Sched& S, const Epi& E) {
    int tid_o = threadIdx.x; asm volatile("" : "+v"(tid_o));
    const int tid = tid_o, wid = __builtin_amdgcn_readfirstlane(tid >> 6), lane = tid & 63, wr = wid >> 2, wc = wid & 3, fr = lane & 15, fq = lane >> 4;
    const int K = g.K, nt = K / BK;
    unsigned voffA[2], voffB[2];
#pragma unroll
    for (int i = 0; i < 2; ++i) { int R, C; stage_rc(tid * 16 + i * 8192, R, C); const int Rb = Epi::PERM ? ((R & ~31) + perm32(R & 31)) : R;
        voffA[i] = (unsigned)(R * K + C) * 2u; voffB[i] = (unsigned)(Rb * K + C) * 2u; }
    const size_t kstep = (size_t)(BK * 2);
    const size_t hstep = (size_t)HALF * K * 2;
    const size_t tstep = 2 * hstep;
    const unsigned ldsw = (unsigned)wid * 1024u;
    const int aoff = lds_byte(wr * 64 + fr, fq * 8), boff = lds_byte(wc * 32 + fr, fq * 8);
#define PG8_SA(b, h) (((b) * 2 + (h)) * HTB)
#define PG8_SB(b, h) ((4 + (b) * 2 + (h)) * HTB)
#define PG8_STAGE(bufoff, gbase, voff) do { _Pragma("unroll") for (int _i = 0; _i < 2; ++_i) \
        __builtin_amdgcn_global_load_lds((const unsigned*)((const char*)(gbase) + (voff)[_i]), (PG8_LAS unsigned*)(lds + (bufoff) + ldsw + _i * 8192), 16, 0, 0); } while (0)
#define PG8_LDA(dst, b, h) do { _Pragma("unroll") for (int m = 0; m < 4; ++m) _Pragma("unroll") for (int k = 0; k < 2; ++k) dst[m][k] = *(const PG8_LAS bf16x8*)(lds + PG8_SA(b, h) + aoff + m * 2048 + k * 1024); } while (0)
#define PG8_LDB(dst, b, h) do { _Pragma("unroll") for (int n = 0; n < 2; ++n) _Pragma("unroll") for (int k = 0; k < 2; ++k) dst[n][k] = *(const PG8_LAS bf16x8*)(lds + PG8_SB(b, h) + boff + n * 2048 + k * 1024); } while (0)
#define PG8_MMA(ai, bj, At, Bt) do { __builtin_amdgcn_s_setprio(1); _Pragma("unroll") for (int m = 0; m < 4; ++m) _Pragma("unroll") for (int n = 0; n < 2; ++n) _Pragma("unroll") for (int k = 0; k < 2; ++k) \
        acc[ai][bj][m][n] = __builtin_amdgcn_mfma_f32_16x16x32_bf16(Bt[n][k], At[m][k], acc[ai][bj][m][n], 0, 0, 0); __builtin_amdgcn_s_setprio(0); } while (0)
#define PG8_WAIT_V(n) asm volatile("s_waitcnt vmcnt(" #n ")" ::: "memory")
#define PG8_WAIT_L(n) asm volatile("s_waitcnt lgkmcnt(" #n ")" ::: "memory")
#define PG8_BAR __builtin_amdgcn_s_barrier()
#define PG8_SCHED __builtin_amdgcn_sched_barrier(0)
    Unit cur, nxt; int ui = 0;
    if (!S.next(0, cur)) return;
    f32x4 acc[2][2][4][2];
#pragma unroll
    for (int a = 0; a < 2; ++a)
#pragma unroll
        for (int b = 0; b < 2; ++b)
#pragma unroll
            for (int m = 0; m < 4; ++m)
#pragma unroll
                for (int n = 0; n < 2; ++n) acc[a][b][m][n] = (f32x4){0.f, 0.f, 0.f, 0.f};
    bf16x8 At[4][2], B0[2][2], B1[2][2];
    const char* cA = (const char*)g.A + (size_t)cur.pm * tstep; const char* cB = (const char*)g.Bt + (size_t)cur.pn * tstep;
    S.a_ready(cur);
    if constexpr (SP2) {
        PG8_STAGE(PG8_SB(0, 0), cB, voffB); PG8_STAGE(PG8_SB(0, 1), cB + hstep, voffB); PG8_STAGE(PG8_SA(0, 0), cA, voffA); PG8_STAGE(PG8_SA(0, 1), cA + hstep, voffA);
        if (wr == 1) PG8_BAR;
        PG8_WAIT_V(2); PG8_BAR;
        PG8_STAGE(PG8_SB(1, 0), cB + kstep, voffB); PG8_STAGE(PG8_SA(1, 0), cA + kstep, voffA); PG8_STAGE(PG8_SB(1, 1), cB + hstep + kstep, voffB);
        PG8_WAIT_V(6); PG8_BAR;
    } else {
        PG8_STAGE(PG8_SB(0, 0), cB, voffB); PG8_STAGE(PG8_SA(0, 0), cA, voffA); PG8_STAGE(PG8_SB(0, 1), cB + hstep, voffB); PG8_STAGE(PG8_SA(0, 1), cA + hstep, voffA);
        if (wr == 1) PG8_BAR;
        PG8_WAIT_V(4); PG8_BAR;
        PG8_STAGE(PG8_SB(1, 0), cB + kstep, voffB); PG8_STAGE(PG8_SA(1, 0), cA + kstep, voffA); PG8_STAGE(PG8_SB(1, 1), cB + hstep + kstep, voffB);
        PG8_WAIT_V(6); PG8_BAR;
    }
    for (;;) {
        const bool has_next = S.next(ui + 1, nxt);
        const char* nA = has_next ? (const char*)g.A + (size_t)nxt.pm * tstep : cA; const char* nB = has_next ? (const char*)g.Bt + (size_t)nxt.pn * tstep : cB;
        for (int t = 0; t < nt; t += 2) {
            const bool last = (t == nt - 2);
            const char* a1 = cA + (size_t)(t + 1) * kstep;
            const char* a2 = last ? nA : cA + (size_t)(t + 2) * kstep; const char* b2 = last ? nB : cB + (size_t)(t + 2) * kstep;
            const char* a3 = a2 + kstep; const char* b3 = b2 + kstep;
            if (last && has_next) S.a_ready(nxt);
            if constexpr (SP2) {
            PG8_LDB(B0, 0, 0); PG8_LDB(B1, 0, 1); PG8_SCHED; PG8_LDA(At, 0, 0); PG8_STAGE(PG8_SA(1, 1), a1 + hstep, voffA);
            PG8_WAIT_V(8); PG8_WAIT_L(0); PG8_BAR; PG8_MMA(0, 0, At, B0); PG8_MMA(0, 1, At, B1); PG8_BAR; PG8_SCHED;
            PG8_LDA(At, 0, 1); PG8_STAGE(PG8_SB(0, 0), b2, voffB); PG8_STAGE(PG8_SB(0, 1), b2 + hstep, voffB); PG8_STAGE(PG8_SA(0, 0), a2, voffA);
            PG8_WAIT_V(8); PG8_WAIT_L(0); PG8_BAR; PG8_MMA(1, 0, At, B0); PG8_MMA(1, 1, At, B1); PG8_BAR; PG8_SCHED;
            PG8_LDB(B0, 1, 0); PG8_LDB(B1, 1, 1); PG8_SCHED; PG8_LDA(At, 1, 0); PG8_STAGE(PG8_SA(0, 1), a2 + hstep, voffA);
            PG8_WAIT_V(8); PG8_WAIT_L(0); PG8_BAR; PG8_MMA(0, 0, At, B0); PG8_MMA(0, 1, At, B1); PG8_BAR; PG8_SCHED;
            PG8_LDA(At, 1, 1); PG8_STAGE(PG8_SB(1, 0), b3, voffB); PG8_STAGE(PG8_SB(1, 1), b3 + hstep, voffB); PG8_STAGE(PG8_SA(1, 0), a3, voffA);
            PG8_WAIT_V(8); PG8_WAIT_L(0); PG8_BAR; PG8_MMA(1, 0, At, B0); PG8_MMA(1, 1, At, B1); PG8_BAR; PG8_SCHED;
            } else {
            PG8_LDB(B0, 0, 0); PG8_SCHED; PG8_LDA(At, 0, 0); PG8_STAGE(PG8_SA(1, 1), a1 + hstep, voffA);
            PG8_WAIT_L(8); PG8_BAR; PG8_WAIT_L(0); PG8_MMA(0, 0, At, B0); PG8_BAR; PG8_SCHED;
            PG8_LDB(B1, 0, 1); PG8_STAGE(PG8_SB(0, 0), b2, voffB);
            PG8_BAR; PG8_WAIT_L(0); PG8_MMA(0, 1, At, B1); PG8_BAR;
            PG8_LDA(At, 0, 1); PG8_STAGE(PG8_SA(0, 0), a2, voffA);
            PG8_BAR; PG8_WAIT_L(0); PG8_MMA(1, 0, At, B0); PG8_BAR; PG8_SCHED;
            PG8_STAGE(PG8_SB(0, 1), b2 + hstep, voffB);
            PG8_WAIT_V(6); PG8_BAR; PG8_MMA(1, 1, At, B1); PG8_BAR;
            PG8_LDB(B0, 1, 0); PG8_SCHED; PG8_LDA(At, 1, 0); PG8_STAGE(PG8_SA(0, 1), a2 + hstep, voffA);
            PG8_WAIT_L(8); PG8_BAR; PG8_WAIT_L(0); PG8_MMA(0, 0, At, B0); PG8_BAR; PG8_SCHED;
            PG8_LDB(B1, 1, 1); PG8_STAGE(PG8_SB(1, 0), b3, voffB);
            PG8_BAR; PG8_WAIT_L(0); PG8_MMA(0, 1, At, B1); PG8_BAR;
            PG8_LDA(At, 1, 1); PG8_STAGE(PG8_SA(1, 0), a3, voffA);
            PG8_BAR; PG8_WAIT_L(0); PG8_MMA(1, 0, At, B0); PG8_BAR; PG8_SCHED;
            PG8_STAGE(PG8_SB(1, 1), b3 + hstep, voffB);
            PG8_WAIT_V(6); PG8_BAR; PG8_MMA(1, 1, At, B1); PG8_BAR;
            }
        }
        if constexpr (ALIGN_EPI) { if (wr == 0) PG8_BAR; }
        if constexpr (!Epi::AFTER_DRAIN) { E(acc, cur, wr, wc, fr, fq); S.done(cur); }
        if (!has_next) break;
#pragma unroll
        for (int a = 0; a < 2; ++a)
#pragma unroll
            for (int b = 0; b < 2; ++b)
#pragma unroll
                for (int m = 0; m < 4; ++m)
#pragma unroll
                    for (int n = 0; n < 2; ++n) acc[a][b][m][n] = (f32x4){0.f, 0.f, 0.f, 0.f};
        cur = nxt; cA = nA; cB = nB; ++ui;
        if constexpr (ALIGN_EPI) { if (wr == 1) PG8_BAR; }
    }
    PG8_WAIT_V(0);
    if constexpr (!ALIGN_EPI) { if (wr == 0) PG8_BAR; }
    PG8_BAR;
    if constexpr (Epi::AFTER_DRAIN) { E.fused(acc, cur, wr, wc, fr, fq, lds, wid, lane); S.done(cur); }
#undef PG8_SA
#undef PG8_SB
#undef PG8_STAGE
#undef PG8_LDA
#undef PG8_LDB
#undef PG8_MMA
#undef PG8_WAIT_V
#undef PG8_WAIT_L
#undef PG8_BAR
#undef PG8_SCHED
}
}

constexpr int NWAVES = 8, NTHR = NWAVES * 64;
constexpr int NT = 8192, DM = 2048, SEQ = 2048, NB = 4;
constexpr int INC = 7176, PROJW = 7168;
constexpr int NEXP = 16384;
constexpr float EPS = 1e-6f;
constexpr size_t MiB = 1u << 20;
constexpr size_t WS_CTL = 0, CTL_ZERO_BYTES = 1 * MiB;
constexpr size_t WS_WIN = 2 * MiB, WS_WOUT = 30 * MiB, WS_WQ = 38 * MiB, WS_WG = 46 * MiB, WS_WP = 54 * MiB, WS_KEYS = 55 * MiB, WS_P16 = 56 * MiB;
constexpr size_t WS_GI = 60 * MiB, WS_BLOC = 61 * MiB, WS_MT = 61 * MiB + 512 * 1024, WS_SCAL = 62 * MiB, WS_LBUF = 62 * MiB + 256 * 1024, WS_NBUF = 62 * MiB + 512 * 1024;
constexpr size_t WS_PART = 63 * MiB, WS_PART2 = 64 * MiB, WS_IDX = 65 * MiB, WS_GW = 69 * MiB, WS_RS2 = 73 * MiB, WS_PART3 = 74 * MiB;
constexpr size_t WS_PA = 240 * MiB;
constexpr size_t WS_U8 = 80 * MiB, WS_V8 = 112 * MiB;
constexpr size_t WS_XN = 208 * MiB;
constexpr size_t WS_PROJ = 240 * MiB, WS_PP = 352 * MiB;
constexpr size_t WS_Y = 384 * MiB;
constexpr size_t WS_UBUF = 416 * MiB;
constexpr size_t WS_END = 480 * MiB;
constexpr int CW_BAR = 4096;
constexpr int LDS_BYTES = 147456;
constexpr int R0_OFF = 0, R1_OFF = 69632, ARR_OFF = 139264, RS_OFF = 145408, MISC_OFF = 146432;

#define GAS __attribute__((address_space(1)))
#define LAS __attribute__((address_space(3)))
typedef unsigned short bf16;
typedef unsigned v4u __attribute__((ext_vector_type(4)));
typedef unsigned v2u __attribute__((ext_vector_type(2)));
typedef float f32x4 __attribute__((ext_vector_type(4)));
typedef short bf16x8 __attribute__((ext_vector_type(8)));
#define LDS_WAIT() asm volatile("s_waitcnt lgkmcnt(0)" ::: "memory")
__device__ __forceinline__ unsigned f2bf(float f) { unsigned u = __builtin_bit_cast(unsigned, f); return (u + 0x7fffu + ((u >> 16) & 1u)) >> 16; }
__device__ __forceinline__ unsigned pk2(float lo, float hi) { return f2bf(lo) | (f2bf(hi) << 16); }
__device__ __forceinline__ float bflo(unsigned w) { return __uint_as_float(w << 16); }
__device__ __forceinline__ float bfhi(unsigned w) { return __uint_as_float(w & 0xffff0000u); }
__device__ __forceinline__ float wave_sum(float v) {
#pragma unroll
    for (int o = 1; o < 64; o <<= 1) v += __shfl_xor(v, o);
    return v;
}

#define XB_TMO      128
#define XB_XCNT(j)  (256  + 64 * (j))
#define XB_XSUB(j)  (1280 + 64 * (j))
#define XB_XGEN(j)  (2304 + 64 * (j))
#define XB_TOP      3328
#define XB_TOPGEN   3392
#define XCD_BAR_WORDS 3456
#define XB_SPIN_CAP (1u << 18)
__device__ __forceinline__ unsigned xb_ld(unsigned* p)              { return __hip_atomic_load(p, __ATOMIC_RELAXED, __HIP_MEMORY_SCOPE_AGENT); }
__device__ __forceinline__ unsigned xb_add(unsigned* p, unsigned v) { return __hip_atomic_fetch_add(p, v, __ATOMIC_RELAXED, __HIP_MEMORY_SCOPE_AGENT); }
__device__ __forceinline__ unsigned xb_xcc_id() { return (unsigned)__builtin_amdgcn_s_getreg((3 << 11) | 20) & 0xFu; }
#define XB_SPIN(cond, bar) do { unsigned _sp = 0; while (cond) { __builtin_amdgcn_s_sleep(1); \
    if ((++_sp & 255u) == 0u) { if (xb_ld(&(bar)[XB_TMO])) break; if (_sp > XB_SPIN_CAP) { atomicAdd(&(bar)[XB_TMO], 1u); break; } } } } while (0)
struct XcdBarrier { unsigned* bar; unsigned x; volatile LAS unsigned* st; };
__device__ __forceinline__ XcdBarrier xcd_barrier_post(unsigned* bar, volatile LAS unsigned* st) {
    XcdBarrier b; b.bar = bar; b.x = xb_xcc_id(); b.st = st;
    if (threadIdx.x == 0) (void)xb_add(&bar[XB_XCNT(b.x)], 1u);
    return b;
}
__device__ __forceinline__ void xcd_barrier_complete(unsigned* bar, unsigned x, unsigned& nloc, unsigned& nx) {
    const unsigned G = gridDim.x * gridDim.y * gridDim.z;
    unsigned sum, cnt, mine, sp = 0u;
    for (;;) {
        sum = 0u; cnt = 0u; mine = 0u;
#pragma unroll
        for (unsigned j = 0; j < 16; ++j) { const unsigned c = xb_ld(&bar[XB_XCNT(j)]); sum += c; cnt += (c > 0u) ? 1u : 0u; mine = (j == x) ? c : mine; }
        if (sum == G) break;
        __builtin_amdgcn_s_sleep(1);
        if ((++sp & 255u) == 0u) { if (xb_ld(&bar[XB_TMO])) break; if (sp > XB_SPIN_CAP) { atomicAdd(&bar[XB_TMO], 1u); break; } }
    }
    nloc = mine > 0u ? mine : 1u; nx = cnt > 0u ? cnt : 1u;
}
__device__ __forceinline__ void xcd_barrier(const XcdBarrier& b) {
    asm volatile("s_waitcnt vmcnt(0)" ::: "memory");
    __syncthreads();
    if (threadIdx.x == 0) {
        unsigned* bar = b.bar;
        __builtin_amdgcn_s_waitcnt(0);
        unsigned nloc = b.st[0], nx = b.st[1];
        if (nloc == 0u) { xcd_barrier_complete(bar, b.x, nloc, nx); b.st[0] = nloc; b.st[1] = nx; }
        const unsigned old = xb_add(&bar[XB_XSUB(b.x)], 1u);
        const unsigned gen = old / nloc;
        if (old + 1u == (gen + 1u) * nloc) {
            __builtin_amdgcn_fence(__ATOMIC_RELEASE, "agent");
            asm volatile("s_waitcnt vmcnt(0)" ::: "memory");
            const unsigned og = xb_add(&bar[XB_TOP], 1u);
            const unsigned tg = og / nx;
            if (og + 1u == (tg + 1u) * nx) xb_add(&bar[XB_TOPGEN], 1u);
            else XB_SPIN(xb_ld(&bar[XB_TOPGEN]) == tg, bar);
            __builtin_amdgcn_fence(__ATOMIC_ACQUIRE, "agent");
            xb_add(&bar[XB_XGEN(b.x)], 1u);
            asm volatile("s_waitcnt vmcnt(0)" ::: "memory");
        } else {
            XB_SPIN(xb_ld(&bar[XB_XGEN(b.x)]) == gen, bar);
            __builtin_amdgcn_fence(__ATOMIC_ACQUIRE, "agent");
            asm volatile("s_waitcnt vmcnt(0)" ::: "memory");
        }
    }
    __syncthreads();
}

struct Args { const float* in[17]; float* out; unsigned char* ws; unsigned long long pad; };

__device__ __forceinline__ void p0_transpose_item(const float* W, int ldw, int K, bf16* WT, int nblk, int item, LAS float* scr, int lane, const float* kscale) {
    const int kb = item / nblk, nb = item % nblk, k0 = 64 * kb, n0 = 32 * nb;
#pragma unroll 8
    for (int i = 0; i < 32; ++i) { const int kk = 2 * i + (lane >> 5); float v = W[(size_t)(k0 + kk) * ldw + n0 + (lane & 31)]; if (kscale) v *= kscale[k0 + kk]; scr[kk * 33 + (lane & 31)] = v; }
    LDS_WAIT(); asm volatile("" ::: "memory");
    const int c = lane & 7;
#pragma unroll
    for (int j = 0; j < 4; ++j) { const int n = (lane >> 3) + 8 * j; const LAS float* s = scr + (8 * c) * 33 + n;
        v4u o; o.x = pk2(s[0 * 33], s[1 * 33]); o.y = pk2(s[2 * 33], s[3 * 33]); o.z = pk2(s[4 * 33], s[5 * 33]); o.w = pk2(s[6 * 33], s[7 * 33]);
        *(GAS v4u*)(WT + (size_t)(n0 + n) * K + k0 + 8 * c) = o; }
    LDS_WAIT(); asm volatile("" ::: "memory");
}
__device__ __forceinline__ void cvt_stream(const float* src, bf16* dst, size_t n8, size_t gtid, size_t nthr) {
    for (size_t i = gtid; i < n8; i += nthr) { const f32x4 a = ((const GAS f32x4*)src)[2 * i], b = ((const GAS f32x4*)src)[2 * i + 1];
        v4u o; o.x = pk2(a.x, a.y); o.y = pk2(a.z, a.w); o.z = pk2(b.x, b.y); o.w = pk2(b.z, b.w); ((GAS v4u*)dst)[i] = o; }
}
__device__ __forceinline__ void cvt_stream_fp8(const float* src, unsigned char* dst, size_t n16, size_t gtid, size_t nthr) {
#pragma unroll 2
    for (size_t i = gtid; i < n16; i += nthr) { const GAS f32x4* s = (const GAS f32x4*)src + 4 * i; v4u o;
#pragma unroll
        for (int q = 0; q < 4; ++q) { const f32x4 a = s[q] * 256.0f; int w = 0; w = __builtin_amdgcn_cvt_pk_fp8_f32(a.x, a.y, w, false); w = __builtin_amdgcn_cvt_pk_fp8_f32(a.z, a.w, w, true); o[q] = (unsigned)w; }
        ((GAS v4u*)dst)[i] = o; }
}
__device__ __forceinline__ float log_sigmoid(float x) { return fminf(x, 0.f) - log1pf(expf(-fabsf(x))); }

__device__ __forceinline__ void phase0(const Args& A, LAS unsigned char* lds, int tid, int lane, int wave) {
    unsigned char* ws = A.ws;
    const int G = gridDim.x, gw = blockIdx.x * NWAVES + wave, NGW = G * NWAVES;
    const size_t gtid = (size_t)blockIdx.x * NTHR + tid, nthr = (size_t)G * NTHR;
    {
        LAS float* scr = (LAS float*)(lds + wave * 16384);
        constexpr int I_IN = 32 * 224, I_SQ = 32 * 64, I_P = 4 * 64;
        constexpr int NITEMS = I_IN + 3 * I_SQ + I_P;
        for (int it = gw; it < NITEMS; it += NGW) {
            int r = it;
            if (r < I_IN) { p0_transpose_item(A.in[3], INC, DM, (bf16*)(ws + WS_WIN), 224, r, scr, lane, nullptr); continue; } r -= I_IN;
            if (r < I_SQ) { p0_transpose_item(A.in[7], DM, DM, (bf16*)(ws + WS_WOUT), 64, r, scr, lane, nullptr); continue; } r -= I_SQ;
            if (r < I_SQ) { p0_transpose_item(A.in[9], DM, DM, (bf16*)(ws + WS_WQ), 64, r, scr, lane, A.in[8]); continue; } r -= I_SQ;
            if (r < I_SQ) { p0_transpose_item(A.in[14], DM, DM, (bf16*)(ws + WS_WG), 64, r, scr, lane, A.in[13]); continue; } r -= I_SQ;
            p0_transpose_item(A.in[15], DM, 256, (bf16*)(ws + WS_WP), 64, r, scr, lane, nullptr);
        }
    }
    cvt_stream(A.in[10], (bf16*)(ws + WS_KEYS), (size_t)8 * 2 * 128 * 128 / 8, gtid, nthr);
    cvt_stream(A.in[1], (bf16*)(ws + WS_P16), (size_t)NT * 256 / 8, gtid, nthr);
    cvt_stream_fp8(A.in[11], ws + WS_U8, (size_t)NEXP * DM / 16, gtid, nthr);
    cvt_stream_fp8(A.in[12], ws + WS_V8, (size_t)NEXP * DM / 16, gtid, nthr);
    __syncthreads();
    LAS float* wg8 = (LAS float*)lds;
    for (int i = tid; i < DM * 8; i += NTHR) wg8[i] = A.in[3][(size_t)(i >> 3) * INC + PROJW + (i & 7)];
    __syncthreads();
    {
        const float* x = A.in[0]; const float* g = A.in[2]; const float* gb = A.in[5];
        bf16* XN = (bf16*)(ws + WS_XN); float* GI = (float*)(ws + WS_GI);
        f32x4 gv[8];
#pragma unroll
        for (int j = 0; j < 8; ++j) gv[j] = ((const GAS f32x4*)g)[lane + 64 * j];
        for (int t = gw; t < NT; t += NGW) {
            const GAS f32x4* xr = (const GAS f32x4*)(x + (size_t)t * DM) + lane;
            f32x4 v[8]; float ss = 0.f;
#pragma unroll
            for (int j = 0; j < 8; ++j) { v[j] = xr[64 * j]; ss += (v[j].x * v[j].x + v[j].y * v[j].y) + (v[j].z * v[j].z + v[j].w * v[j].w); }
            const float rstd = 1.0f / sqrtf(wave_sum(ss) * (1.0f / DM) + EPS);
            float ga[8];
#pragma unroll
            for (int c = 0; c < 8; ++c) ga[c] = 0.f;
            GAS v2u* o8 = (GAS v2u*)(XN + (size_t)t * DM) + lane;
#pragma unroll
            for (int j = 0; j < 8; ++j) {
                f32x4 xn = v[j] * rstd * gv[j];
                v2u o; o.x = pk2(xn.x, xn.y); o.y = pk2(xn.z, xn.w); o8[64 * j] = o;
#pragma unroll
                for (int i = 0; i < 4; ++i) { const int e = 4 * lane + 256 * j + i; const f32x4 w0 = *(const LAS f32x4*)(wg8 + e * 8), w1 = *(const LAS f32x4*)(wg8 + e * 8 + 4); const float xv = xn[i];
                    ga[0] += xv * w0.x; ga[1] += xv * w0.y; ga[2] += xv * w0.z; ga[3] += xv * w0.w; ga[4] += xv * w1.x; ga[5] += xv * w1.y; ga[6] += xv * w1.z; ga[7] += xv * w1.w; }
                asm volatile("" ::: "memory");
            }
            float outv = 0.f;
#pragma unroll
            for (int c = 0; c < 8; ++c) { const float s = wave_sum(ga[c]); if (lane == c) outv = s; }
            if (lane < 8) { float val = outv + gb[lane]; if (lane >= 4) val = log_sigmoid(val); GI[(size_t)t * 8 + lane] = val; }
        }
    }
}

constexpr int TRS = 272;
constexpr int NRS = 528;
constexpr int A_BL = 0, A_PML = 16, A_BS = 32, A_IS = 160, A_PMS = 288, A_WV = 416, A_MT = 544, A_NL = 672;

__device__ __forceinline__ void phase_x1(const Args& A, LAS unsigned char* lds, int tid, int lane, int wave) {
    unsigned char* ws = A.ws;
    const float* GI = (const float*)(ws + WS_GI); const bf16* PROJ = (const bf16*)(ws + WS_PROJ);
    float* BLOC = (float*)(ws + WS_BLOC); float* MT = (float*)(ws + WS_MT); float* SCAL = (float*)(ws + WS_SCAL); float* LBUF = (float*)(ws + WS_LBUF); float* UBUF = (float*)(ws + WS_UBUF);
    LAS float* arr = (LAS float*)(lds + ARR_OFF);
    const int lm = lane & 15, g = lane >> 4;
    for (int u = blockIdx.x; u < 256; u += gridDim.x) {
        const int c = u & 15, h = (u >> 4) & 3, b = u >> 6;
        const int t0 = b * SEQ + c * 128;
        __syncthreads();
#pragma unroll
        for (int rep = 0; rep < 2; ++rep) {
            const int cc = wave + 8 * rep;
            if (cc <= c) {
                const size_t tt = (size_t)(b * SEQ + cc * 128 + 2 * lane);
                const float i0 = GI[tt * 8 + h], i1 = GI[(tt + 1) * 8 + h], lf0 = GI[tt * 8 + 4 + h], lf1 = GI[(tt + 1) * 8 + 4 + h];
                const float p = lf0 + lf1; float incl = p;
#pragma unroll
                for (int o = 1; o < 64; o <<= 1) { const float y = __shfl_up(incl, o); if (lane >= o) incl += y; }
                const float excl = incl - p, b0 = excl + lf0, b1 = incl;
                const float g0 = i0 - b0, g1 = i1 - b1, q = fmaxf(g0, g1); float im = q;
#pragma unroll
                for (int o = 1; o < 64; o <<= 1) { const float y = __shfl_up(im, o); if (lane >= o) im = fmaxf(im, y); }
                float em = __shfl_up(im, 1); if (lane == 0) em = -INFINITY;
                if (lane == 63) { arr[A_BL + cc] = incl; arr[A_PML + cc] = im; }
                if (cc == c) { arr[A_BS + 2 * lane] = b0; arr[A_BS + 2 * lane + 1] = b1; arr[A_IS + 2 * lane] = i0; arr[A_IS + 2 * lane + 1] = i1;
                    arr[A_PMS + 2 * lane] = fmaxf(em, g0); arr[A_PMS + 2 * lane + 1] = im; }
            }
        }
        __syncthreads();
        float mprev = 0.f;
        for (int cc = 0; cc < c; ++cc) mprev = arr[A_BL + cc] + fmaxf(mprev, arr[A_PML + cc]);
        const float blast = arr[A_BL + c];
        const float mnew = arr[A_BS + 127] + fmaxf(mprev, arr[A_PMS + 127]);
        if (tid < 128) {
            const float bt = arr[A_BS + tid], mt = bt + fmaxf(mprev, arr[A_PMS + tid]);
            arr[A_WV + tid] = expf(blast - bt + arr[A_IS + tid] - mnew) * 0.0625f;
            BLOC[(size_t)(t0 + tid) * 4 + h] = bt; MT[(size_t)(t0 + tid) * 4 + h] = mt;
        }
        if (tid == 0) { SCAL[u * 4 + 0] = expf(blast + mprev - mnew); SCAL[u * 4 + 1] = mprev; }
        __syncthreads();
#pragma unroll
        for (int it = 0; it < 4; ++it) {
            const int d0 = (wave * 4 + it) * 8;
            const bf16* r0p = PROJ + (size_t)(t0 + 2 * lane) * PROJW + h * 256 + d0;
            const v4u k0 = *(const GAS v4u*)(r0p + 4096), k1 = *(const GAS v4u*)(r0p + 4096 + PROJW);
            const v4u v0 = *(const GAS v4u*)(r0p + 5120), v1 = *(const GAS v4u*)(r0p + 5120 + PROJW);
            const float w0 = arr[A_WV + 2 * lane], w1 = arr[A_WV + 2 * lane + 1];
#pragma unroll
            for (int j = 0; j < 4; ++j) {
                const unsigned ka = k0[j], kb = k1[j], va = v0[j], vb = v1[j];
                *(LAS unsigned*)(lds + R0_OFF + (d0 + 2 * j) * TRS + 4 * lane) = (ka & 0xffffu) | (kb << 16);
                *(LAS unsigned*)(lds + R0_OFF + (d0 + 2 * j + 1) * TRS + 4 * lane) = (ka >> 16) | (kb & 0xffff0000u);
                *(LAS unsigned*)(lds + R1_OFF + (d0 + 2 * j) * TRS + 4 * lane) = pk2(bflo(va) * w0, bflo(vb) * w1);
                *(LAS unsigned*)(lds + R1_OFF + (d0 + 2 * j + 1) * TRS + 4 * lane) = pk2(bfhi(va) * w0, bfhi(vb) * w1);
            }
        }
        __syncthreads();
        if (tid < 256) {
            float s = 0.f;
#pragma unroll 4
            for (int s8 = 0; s8 < 16; ++s8) { const v4u kv = *(const LAS v4u*)(lds + R0_OFF + tid * TRS + s8 * 16);
#pragma unroll
                for (int j = 0; j < 4; ++j) s += bflo(kv[j]) * arr[A_WV + s8 * 8 + 2 * j] + bfhi(kv[j]) * arr[A_WV + s8 * 8 + 2 * j + 1]; }
            LBUF[u * 256 + tid] = s;
        }
        float* Uo = UBUF + (size_t)u * 65536;
#pragma unroll 1
        for (int dh = 0; dh < 2; ++dh) {
            f32x4 acc[2][8];
#pragma unroll
            for (int i = 0; i < 2; ++i)
#pragma unroll
                for (int j = 0; j < 8; ++j) acc[i][j] = (f32x4){0.f, 0.f, 0.f, 0.f};
#pragma unroll
            for (int kk = 0; kk < 4; ++kk) {
                bf16x8 af[2];
#pragma unroll
                for (int i = 0; i < 2; ++i) af[i] = *(const LAS bf16x8*)(lds + R1_OFF + (32 * wave + 16 * i + lm) * TRS + (32 * kk + 8 * g) * 2);
#pragma unroll
                for (int j = 0; j < 8; ++j) { const bf16x8 bfr = *(const LAS bf16x8*)(lds + R0_OFF + (128 * dh + 16 * j + lm) * TRS + (32 * kk + 8 * g) * 2);
#pragma unroll
                    for (int i = 0; i < 2; ++i) acc[i][j] = __builtin_amdgcn_mfma_f32_16x16x32_bf16(af[i], bfr, acc[i][j], 0, 0, 0); }
            }
#pragma unroll
            for (int i = 0; i < 2; ++i)
#pragma unroll
                for (int j = 0; j < 8; ++j)
#pragma unroll
                    for (int r = 0; r < 4; ++r) Uo[(size_t)(32 * wave + 16 * i + 4 * g + r) * 256 + 128 * dh + 16 * j + lm] = acc[i][j][r];
        }
    }
}

__device__ __forceinline__ void phase_x2(const Args& A, int tid) {
    unsigned char* ws = A.ws;
    const float* SCAL = (const float*)(ws + WS_SCAL); const float* LBUF = (const float*)(ws + WS_LBUF); const float* UBUF = (const float*)(ws + WS_UBUF);
    float* NBUF = (float*)(ws + WS_NBUF); bf16* CT = (bf16*)(ws + WS_XN);
    const bf16* PROJ = (const bf16*)(ws + WS_PROJ); bf16* Y = (bf16*)(ws + WS_Y);
    const size_t gtid = (size_t)blockIdx.x * NTHR + tid, nthr = (size_t)gridDim.x * NTHR;
    for (size_t it = gtid; it < (size_t)16 * 16384; it += nthr) {
        const int bh = (int)(it >> 14), r = (int)(it & 16383);
        f32x4 C = (f32x4){0.f, 0.f, 0.f, 0.f};
#pragma unroll 5
        for (int c = 0; c < 15; ++c) { const int u = bh * 16 + c; const float a = SCAL[u * 4];
            const f32x4 uv = *(const GAS f32x4*)(UBUF + (size_t)u * 65536 + (size_t)r * 4); C = C * a + uv;
            v2u o; o.x = pk2(C.x, C.y); o.y = pk2(C.z, C.w); *(GAS v2u*)(CT + (size_t)(u + 1) * 65536 + (size_t)r * 4) = o; }
    }
    for (size_t it = gtid; it < 4096; it += nthr) {
        const int bh = (int)(it >> 8), d = (int)(it & 255); float n = 0.f;
        for (int c = 0; c < 15; ++c) { const int u = bh * 16 + c; n = n * SCAL[u * 4] + LBUF[u * 256 + d]; NBUF[(u + 1) * 256 + d] = n; }
    }
    const float* cw = A.in[4];
    for (size_t it = gtid; it < (size_t)NT * 128; it += nthr) {
        const int t = (int)(it >> 7), c0 = (int)(it & 127) * 8, s = t & (SEQ - 1);
        const bf16* row = PROJ + (size_t)t * PROJW + c0;
        const v4u bc = *(const GAS v4u*)row, cc0 = *(const GAS v4u*)(row + 1024), uc0 = *(const GAS v4u*)(row + 2048);
        v4u cc1 = (v4u){0, 0, 0, 0}, uc1 = cc1, cc2 = cc1, uc2 = cc1;
        if (s >= 1) { cc1 = *(const GAS v4u*)(row - PROJW + 1024); uc1 = *(const GAS v4u*)(row - PROJW + 2048); }
        if (s >= 2) { cc2 = *(const GAS v4u*)(row - 2 * PROJW + 1024); uc2 = *(const GAS v4u*)(row - 2 * PROJW + 2048); }
        float w0[8], w1[8], w2[8];
#pragma unroll
        for (int i = 0; i < 8; ++i) { w0[i] = cw[c0 + i]; w1[i] = cw[1024 + c0 + i]; w2[i] = cw[2048 + c0 + i]; }
        v4u o;
#pragma unroll
        for (int j = 0; j < 4; ++j) {
            const float ylo = bflo(bc[j]) * (w0[2 * j] * (bflo(cc2[j]) * bflo(uc2[j])) + w1[2 * j] * (bflo(cc1[j]) * bflo(uc1[j])) + w2[2 * j] * (bflo(cc0[j]) * bflo(uc0[j])));
            const float yhi = bfhi(bc[j]) * (w0[2 * j + 1] * (bfhi(cc2[j]) * bfhi(uc2[j])) + w1[2 * j + 1] * (bfhi(cc1[j]) * bfhi(uc1[j])) + w2[2 * j + 1] * (bfhi(cc0[j]) * bfhi(uc0[j])));
            o[j] = pk2(ylo, yhi);
        }
        *(GAS v4u*)(Y + (size_t)t * DM + c0) = o;
    }
}

__device__ __forceinline__ void phase_x3(const Args& A, LAS unsigned char* lds, int tid, int lane, int wave) {
    unsigned char* ws = A.ws;
    const float* GI = (const float*)(ws + WS_GI); const bf16* PROJ = (const bf16*)(ws + WS_PROJ);
    const float* BLOC = (const float*)(ws + WS_BLOC); const float* MT = (const float*)(ws + WS_MT); const float* SCAL = (const float*)(ws + WS_SCAL); const float* NBUF = (const float*)(ws + WS_NBUF);
    const bf16* CT = (const bf16*)(ws + WS_XN); bf16* Y = (bf16*)(ws + WS_Y);
    const float* gm = A.in[6];
    LAS float* arr = (LAS float*)(lds + ARR_OFF);
    const int lm = lane & 15, g = lane >> 4;
    for (int u = blockIdx.x; u < 256; u += gridDim.x) {
        const int c = u & 15, h = (u >> 4) & 3, b = u >> 6;
        const int t0 = b * SEQ + c * 128;
        const float mprev = SCAL[u * 4 + 1];
        __syncthreads();
        if (tid < 128) { arr[A_BS + tid] = BLOC[(size_t)(t0 + tid) * 4 + h]; arr[A_MT + tid] = MT[(size_t)(t0 + tid) * 4 + h]; arr[A_IS + tid] = GI[(size_t)(t0 + tid) * 8 + h]; }
        if (tid < 256) arr[A_NL + tid] = (c > 0) ? NBUF[u * 256 + tid] : 0.f;
        const bf16* qp = PROJ + (size_t)(t0 + 16 * wave + lm) * PROJW + 3072 + h * 256 + 8 * g;
        float qn = 0.f;
        f32x4 acc[16];
#pragma unroll
        for (int j = 0; j < 16; ++j) acc[j] = (f32x4){0.f, 0.f, 0.f, 0.f};
        if (c > 0) {
            const bf16* ct = CT + (size_t)u * 65536;
#pragma unroll 4
            for (int i = 0; i < 16; ++i) { const int q = tid + NTHR * i, e = q >> 5, ch = q & 31;
                const v4u v = *(const GAS v4u*)(ct + (size_t)e * 256 + ch * 8);
                *(LAS v4u*)(lds + (e < 128 ? R0_OFF + e * NRS : R1_OFF + (e - 128) * NRS) + ch * 16) = v; }
            __syncthreads();
            bf16x8 qa = *(const GAS bf16x8*)qp;
#pragma unroll
            for (int kk = 0; kk < 8; ++kk) {
                const bf16x8 qnx = *(const GAS bf16x8*)(qp + 32 * (kk < 7 ? kk + 1 : 7));
#pragma unroll
                for (int j = 0; j < 16; ++j) { const bf16x8 bfr = *(const LAS bf16x8*)(lds + (j < 8 ? R0_OFF : R1_OFF) + (16 * (j & 7) + lm) * NRS + (32 * kk + 8 * g) * 2);
                    acc[j] = __builtin_amdgcn_mfma_f32_16x16x32_bf16(qa, bfr, acc[j], 0, 0, 0); }
#pragma unroll
                for (int jj = 0; jj < 8; ++jj) qn += __uint_as_float(((unsigned)(unsigned short)qa[jj]) << 16) * arr[A_NL + 32 * kk + 8 * g + jj];
                asm volatile("" ::: "memory");
                qa = qnx;
            }
        } else { __syncthreads(); }
        float at[4];
#pragma unroll
        for (int r = 0; r < 4; ++r) { const int t = 16 * wave + 4 * g + r; at[r] = expf(arr[A_BS + t] + mprev - arr[A_MT + t]); }
        qn += __shfl_xor(qn, 16); qn += __shfl_xor(qn, 32);
#pragma unroll
        for (int j = 0; j < 16; ++j)
#pragma unroll
            for (int r = 0; r < 4; ++r) acc[j][r] *= at[r];
        __syncthreads();
        {
#pragma unroll
            for (int i = 0; i < 8; ++i) { const int q = tid + NTHR * i, s = q >> 5, ch = q & 31;
                const v4u v = *(const GAS v4u*)(PROJ + (size_t)(t0 + s) * PROJW + 4096 + h * 256 + ch * 8);
                *(LAS v4u*)(lds + R0_OFF + s * NRS + ch * 16) = v; }
#pragma unroll
            for (int it = 0; it < 4; ++it) {
                const int d0 = (wave * 4 + it) * 8;
                const bf16* r0p = PROJ + (size_t)(t0 + 2 * lane) * PROJW + 5120 + h * 256 + d0;
                const v4u v0 = *(const GAS v4u*)r0p, v1 = *(const GAS v4u*)(r0p + PROJW);
#pragma unroll
                for (int j = 0; j < 4; ++j) {
                    const unsigned va = v0[j], vb = v1[j];
                    *(LAS unsigned*)(lds + R1_OFF + (d0 + 2 * j) * TRS + 4 * lane) = (va & 0xffffu) | (vb << 16);
                    *(LAS unsigned*)(lds + R1_OFF + (d0 + 2 * j + 1) * TRS + 4 * lane) = (va >> 16) | (vb & 0xffff0000u);
                }
            }
        }
        __syncthreads();
        f32x4 sacc[8];
#pragma unroll
        for (int j = 0; j < 8; ++j) sacc[j] = (f32x4){0.f, 0.f, 0.f, 0.f};
        {
            bf16x8 qa = *(const GAS bf16x8*)qp;
#pragma unroll
            for (int kk = 0; kk < 8; ++kk) {
                const bf16x8 qnx = *(const GAS bf16x8*)(qp + 32 * (kk < 7 ? kk + 1 : 7));
#pragma unroll
                for (int j = 0; j < 8; ++j) { const bf16x8 bfr = *(const LAS bf16x8*)(lds + R0_OFF + (16 * j + lm) * NRS + (32 * kk + 8 * g) * 2);
                    sacc[j] = __builtin_amdgcn_mfma_f32_16x16x32_bf16(qa, bfr, sacc[j], 0, 0, 0); }
                asm volatile("" ::: "memory");
                qa = qnx;
            }
        }
        float rb[4], mtr[4], dsum[4];
#pragma unroll
        for (int r = 0; r < 4; ++r) { const int t = 16 * wave + 4 * g + r; mtr[r] = arr[A_MT + t]; rb[r] = arr[A_BS + t] - mtr[r]; dsum[r] = 0.f; }
#pragma unroll
        for (int j = 0; j < 8; ++j) { const int s = 16 * j + lm; const float cb = arr[A_IS + s] - arr[A_BS + s];
#pragma unroll
            for (int r = 0; r < 4; ++r) { const int t = 16 * wave + 4 * g + r; const float p = (s <= t) ? sacc[j][r] * 0.0625f * __expf(rb[r] + cb) : 0.f; sacc[j][r] = p; dsum[r] += p; } }
#pragma unroll
        for (int r = 0; r < 4; ++r) { float d = dsum[r]; d += __shfl_xor(d, 1); d += __shfl_xor(d, 2); d += __shfl_xor(d, 4); d += __shfl_xor(d, 8); dsum[r] = d; }
        __syncthreads();
#pragma unroll
        for (int j = 0; j < 8; ++j)
#pragma unroll
            for (int r = 0; r < 4; ++r) *(LAS unsigned short*)(lds + R0_OFF + (16 * wave + 4 * g + r) * TRS + (16 * j + lm) * 2) = (unsigned short)f2bf(sacc[j][r]);
        __syncthreads();
#pragma unroll
        for (int kk = 0; kk < 4; ++kk) {
            const bf16x8 pa = *(const LAS bf16x8*)(lds + R0_OFF + (16 * wave + lm) * TRS + (32 * kk + 8 * g) * 2);
#pragma unroll
            for (int j = 0; j < 16; ++j) { const bf16x8 vb = *(const LAS bf16x8*)(lds + R1_OFF + (16 * j + lm) * TRS + (32 * kk + 8 * g) * 2);
                acc[j] = __builtin_amdgcn_mfma_f32_16x16x32_bf16(pa, vb, acc[j], 0, 0, 0); }
            asm volatile("" ::: "memory");
        }
        float ssq[4], inv[4];
#pragma unroll
        for (int r = 0; r < 4; ++r) { const float qnr = __shfl(qn, 4 * g + r); const float den = at[r] * qnr + dsum[r]; inv[r] = 1.0f / fmaxf(fabsf(den), expf(-mtr[r])); ssq[r] = 0.f; }
#pragma unroll
        for (int j = 0; j < 16; ++j)
#pragma unroll
            for (int r = 0; r < 4; ++r) { const float hv = acc[j][r] * inv[r]; acc[j][r] = hv; ssq[r] += hv * hv; }
#pragma unroll
        for (int r = 0; r < 4; ++r) { float d = ssq[r]; d += __shfl_xor(d, 1); d += __shfl_xor(d, 2); d += __shfl_xor(d, 4); d += __shfl_xor(d, 8); ssq[r] = 1.0f / sqrtf(d * (1.0f / 256.0f) + EPS); }
#pragma unroll
        for (int j = 0; j < 16; ++j) { const int e = 16 * j + lm; const float gmv = gm[h * 256 + e];
#pragma unroll
            for (int r = 0; r < 4; ++r) { const size_t tg = (size_t)(t0 + 16 * wave + 4 * g + r);
                const float o = __uint_as_float(((unsigned)PROJ[tg * PROJW + 6144 + h * 256 + e]) << 16);
                const float yv = (acc[j][r] * ssq[r] * gmv) / (1.0f + __expf(-o));
                Y[tg * DM + 1024 + h * 256 + e] = (bf16)f2bf(yv); }
            asm volatile("" ::: "memory"); }
    }
}

__device__ __forceinline__ unsigned fkey(float v) { const unsigned u = __float_as_uint(v); return (u & 0x80000000u) ? ~u : (u | 0x80000000u); }
__device__ __forceinline__ float fdec(unsigned k) { return __uint_as_float((k & 0x80000000u) ? (k & 0x7fffffffu) : ~k); }
#define TK_CE(a, b) do { const unsigned _t = max((a), (b)); (b) = min((a), (b)); (a) = _t; } while (0)
template <int BASE> __device__ __forceinline__ void tk_sort16(unsigned (&v)[64]) {
#pragma unroll
    for (int k = 2; k <= 16; k <<= 1)
#pragma unroll
        for (int j = k >> 1; j > 0; j >>= 1)
#pragma unroll
            for (int i = 0; i < 16; ++i) { const int l = i ^ j; if (l > i) { if ((i & k) == 0) TK_CE(v[BASE + i], v[BASE + l]); else TK_CE(v[BASE + l], v[BASE + i]); } }
}
template <int A0, int B0> __device__ __forceinline__ void tk_merge16(unsigned (&v)[64]) {
#pragma unroll
    for (int i = 0; i < 16; ++i) v[A0 + i] = max(v[A0 + i], v[B0 + 15 - i]);
#pragma unroll
    for (int j = 8; j > 0; j >>= 1)
#pragma unroll
        for (int i = 0; i < 16; ++i) { const int l = i ^ j; if (l > i) TK_CE(v[A0 + i], v[A0 + l]); }
}

__device__ __forceinline__ void phase5(const Args& A, LAS unsigned char* lds, int tid, int lane, int wave) {
    unsigned char* ws = A.ws;
    const bf16* QP = (const bf16*)(ws + WS_Y); const bf16* KEYS = (const bf16*)(ws + WS_KEYS);
    int* IDX = (int*)(ws + WS_IDX); float* GW = (float*)(ws + WS_GW);
    LAS float* SC = (LAS float*)lds;
    LAS unsigned* LST = (LAS unsigned*)lds;
    const int lm = lane & 15, g = lane >> 4;
    for (int u = blockIdx.x; u < 512; u += gridDim.x) {
        const int tt = u >> 3, h = u & 7;
        __syncthreads();
#pragma unroll 1
        for (int p = 0; p < 2; ++p) {
            f32x4 sacc[8];
#pragma unroll
            for (int j = 0; j < 8; ++j) sacc[j] = (f32x4){0.f, 0.f, 0.f, 0.f};
            const bf16* qp = QP + (size_t)(tt * 128 + 16 * wave + lm) * DM + h * 256 + p * 128 + 8 * g;
            const bf16* kp = KEYS + (size_t)((h * 2 + p) * 128 + lm) * 128 + 8 * g;
#pragma unroll
            for (int kk = 0; kk < 4; ++kk) { const bf16x8 af = *(const GAS bf16x8*)(qp + 32 * kk);
#pragma unroll
                for (int j = 0; j < 8; ++j) { const bf16x8 bfr = *(const GAS bf16x8*)(kp + (size_t)(16 * j) * 128 + 32 * kk);
                    sacc[j] = __builtin_amdgcn_mfma_f32_16x16x32_bf16(af, bfr, sacc[j], 0, 0, 0); } }
#pragma unroll
            for (int j = 0; j < 8; ++j)
#pragma unroll
                for (int r = 0; r < 4; ++r) SC[(p * 128 + 16 * wave + 4 * g + r) * 129 + 16 * j + lm] = sacc[j][r];
        }
        __syncthreads();
        unsigned v[64];
        {
            const int t = (tid >> 1) & 127, half = tid & 1, p = tid >> 8;
            const LAS float* row = SC + (p * 128 + t) * 129;
#pragma unroll
            for (int i = 0; i < 64; ++i) { const int n = 64 * half + ((i + 16 * half) & 63); v[i] = (fkey(row[n]) & ~127u) | (unsigned)(127 - n); }
            tk_sort16<0>(v); tk_sort16<16>(v); tk_sort16<32>(v); tk_sort16<48>(v);
            tk_merge16<0, 16>(v); tk_merge16<32, 48>(v); tk_merge16<0, 32>(v);
#pragma unroll
            for (int j = 0; j < 16; ++j) v[16 + j] = __shfl_xor(v[j], 1);
            tk_merge16<0, 16>(v);
        }
        __syncthreads();
        if ((tid & 1) == 0) { const int t = (tid >> 1) & 127, p = tid >> 8;
#pragma unroll
            for (int j = 0; j < 4; ++j) *(LAS v4u*)(LST + (p * 128 + t) * 16 + 4 * j) = (v4u){v[4 * j], v[4 * j + 1], v[4 * j + 2], v[4 * j + 3]}; }
        __syncthreads();
        {
            const int t = tid >> 2, sub = tid & 3;
            const unsigned long long d0 = sub == 0 ? 0x0706050403020100ull : sub == 1 ? 0x1716151413121110ull : sub == 2 ? 0x5042414033323130ull : 0xf0e0d0c0b0a09080ull;
            const unsigned long long d1 = sub == 0 ? 0x0f0e0d0c0b0a0908ull : sub == 1 ? 0xffffff2423222120ull : sub == 2 ? 0xffffff7170616051ull : 0xffffffffffffffffull;
#pragma unroll
            for (int s = 0; s < 16; ++s) {
                const unsigned ij = (unsigned)((s < 8 ? d0 >> (8 * s) : d1 >> (8 * (s - 8))) & 0xffu);
                const unsigned i = ij >> 4, j = ij & 15u;
                const float sum = fdec(LST[t * 16 + i] & ~127u) + fdec(LST[(128 + t) * 16 + j] & ~127u);
                v[s] = (fkey(sum) & ~255u) | (255u - ij);
            }
            tk_sort16<0>(v);
#pragma unroll
            for (int j = 0; j < 16; ++j) v[16 + j] = __shfl_xor(v[j], 1);
            tk_merge16<0, 16>(v);
#pragma unroll
            for (int j = 0; j < 16; ++j) v[16 + j] = __shfl_xor(v[j], 2);
            tk_merge16<0, 16>(v);
            if (sub == 0) {
                float bs[16]; int ex[16];
#pragma unroll
                for (int k = 0; k < 16; ++k) { const unsigned pos = 255u - (v[k] & 255u), i = pos >> 4, j = pos & 15u;
                    const unsigned k0 = LST[t * 16 + i], k1 = LST[(128 + t) * 16 + j];
                    bs[k] = fdec(k0 & ~127u) + fdec(k1 & ~127u); ex[k] = (127 - (int)(k0 & 127u)) * 128 + (127 - (int)(k1 & 127u)); }
                float mx = bs[0];
#pragma unroll
                for (int k = 1; k < 16; ++k) mx = fmaxf(mx, bs[k]);
                float sum = 0.f;
#pragma unroll
                for (int k = 0; k < 16; ++k) { bs[k] = expf(bs[k] - mx); sum += bs[k]; }
                const float rs = 1.0f / sum;
                const size_t o = ((size_t)(tt * 128 + t) * 8 + h) * 16;
#pragma unroll
                for (int k = 0; k < 4; ++k) { *(GAS v4u*)(IDX + o + 4 * k) = (v4u){(unsigned)ex[4 * k], (unsigned)ex[4 * k + 1], (unsigned)ex[4 * k + 2], (unsigned)ex[4 * k + 3]};
                    *(GAS f32x4*)(GW + o + 4 * k) = (f32x4){bs[4 * k] * rs, bs[4 * k + 1] * rs, bs[4 * k + 2] * rs, bs[4 * k + 3] * rs}; }
            }
        }
    }
}

__device__ __forceinline__ float gelu_erf(float a) { return 0.5f * a * (1.0f + erff(a * 0.70710678118654752f)); }
typedef float f32x2 __attribute__((ext_vector_type(2)));
__device__ __forceinline__ void p6_dot16(const v4u w, const f32x2 (&x)[8], float& p) {
    f32x2 acc = (f32x2){0.f, 0.f};
#pragma unroll
    for (int d = 0; d < 4; ++d) { const int wd = (int)w[d];
        acc = __builtin_elementwise_fma(__builtin_amdgcn_cvt_pk_f32_fp8(wd, false), x[2 * d], acc);
        acc = __builtin_elementwise_fma(__builtin_amdgcn_cvt_pk_f32_fp8(wd, true), x[2 * d + 1], acc); }
    p = acc.x + acc.y;
}
struct P6Ctx { const unsigned char* TAB; const int* IDX; const float* W; const float* H; const float* RS2; const float* gf; float* PA; float* H2; bf16* H2b; float* PART3;
               int xg, tbase, q, c, lane; bool c2, c1, c0, q2, q1, q0; };
template <int HALF_> __device__ __forceinline__ void p6_load_rows(const P6Ctx& X, v4u (&w)[16], const v4u (&ev)[4], int it) {
    const unsigned col0 = 128u * (unsigned)(X.xg + 8 * (it >> 5)) + 16u * (unsigned)X.c;
#pragma unroll
    for (int ii = 8 * HALF_; ii < 8 * HALF_ + 8; ++ii) { const unsigned off = ((ev[ii >> 2][ii & 3] & 16383u) << 11) + col0; w[ii] = *(const GAS v4u*)(X.TAB + off); }
}
__device__ __forceinline__ void p6_load_ev(const P6Ctx& X, v4u (&ev)[4], int it) {
    const int t = X.tbase + 8 * ((it < 63 ? it : 63) & 31); const GAS v4u* ip = (const GAS v4u*)((const char*)X.IDX + (unsigned)((t * 128 + 16 * X.q) * 4));
#pragma unroll
    for (int j = 0; j < 4; ++j) ev[j] = ip[j];
}
template <int step> __device__ __forceinline__ void p6_item(const P6Ctx& X, const v4u (&w)[16], int it, v4u (&wn)[16], v4u (&ev)[4], bool more) {
    const int s = X.xg + 8 * (it >> 5), col0 = 128 * s + 16 * X.c, t = X.tbase + 8 * (it & 31), q = X.q, c = X.c;
    if (step == 0) {
        const float rs = X.RS2[t] * (1.0f / 256.0f);
        f32x2 x[8];
        { const GAS f32x4* hr = (const GAS f32x4*)((const char*)X.H + (unsigned)((t * DM + col0) * 4)); const GAS f32x4* gq = (const GAS f32x4*)((const char*)X.gf + (unsigned)(col0 * 4));
#pragma unroll
          for (int j = 0; j < 4; ++j) { const f32x4 xv = hr[j] * rs * gq[j]; x[2 * j] = (f32x2){xv.x, xv.y}; x[2 * j + 1] = (f32x2){xv.z, xv.w}; } }
        float r8[8], r4[4], r2[2];
#pragma unroll
        for (int j = 0; j < 4; ++j) { float pa, pb; p6_dot16(w[2 * j], x, pa); p6_dot16(w[2 * j + 1], x, pb);
            const float snd = X.c2 ? pa : pb, kp = X.c2 ? pb : pa; r8[j] = kp + __shfl_xor(snd, 4); }
        asm volatile("" ::: "memory");
        if (more) { p6_load_rows<1>(X, wn, ev, it + 1); p6_load_ev(X, ev, it + 2); }
        asm volatile("" ::: "memory");
#pragma unroll
        for (int j = 4; j < 8; ++j) { float pa, pb; p6_dot16(w[2 * j], x, pa); p6_dot16(w[2 * j + 1], x, pb);
            const float snd = X.c2 ? pa : pb, kp = X.c2 ? pb : pa; r8[j] = kp + __shfl_xor(snd, 4); }
#pragma unroll
        for (int j = 0; j < 4; ++j) { const float snd = X.c1 ? r8[2 * j] : r8[2 * j + 1], kp = X.c1 ? r8[2 * j + 1] : r8[2 * j]; r4[j] = kp + __shfl_xor(snd, 2); }
#pragma unroll
        for (int j = 0; j < 2; ++j) { const float snd = X.c0 ? r4[2 * j] : r4[2 * j + 1], kp = X.c0 ? r4[2 * j + 1] : r4[2 * j]; r2[j] = kp + __shfl_xor(snd, 1); }
        GAS float* pa_ = (GAS float*)((char*)X.PA + (unsigned)((s * (NT * 128) + t * 128 + 16 * q + ((c & 1) << 2) + (c & 2) + ((c & 4) >> 2)) * 4));
        pa_[0] = r2[0]; pa_[8] = r2[1];
    } else {
        const unsigned eo = (unsigned)(t * DM + col0 + 2 * q);
        const f32x2 hv = *(const GAS f32x2*)((const char*)X.H + eo * 4u);
        f32x4 wv[4];
        { const GAS f32x4* wp = (const GAS f32x4*)((const char*)X.W + (unsigned)((t * 128 + 16 * q) * 4));
#pragma unroll
          for (int j = 0; j < 4; ++j) wv[j] = wp[j]; }
        f32x2 o[8];
#pragma unroll
        for (int j = 0; j < 8; ++j) o[j] = (f32x2){0.f, 0.f};
#pragma unroll
        for (int ii = 0; ii < 16; ++ii) { const float wkk = wv[ii >> 2][ii & 3]; const f32x2 wk2 = (f32x2){wkk, wkk};
            if (ii == 8) { asm volatile("" ::: "memory"); if (more) { p6_load_rows<1>(X, wn, ev, it + 1); p6_load_ev(X, ev, it + 2); } asm volatile("" ::: "memory"); }
#pragma unroll
            for (int d = 0; d < 4; ++d) { const int wd = (int)w[ii][d];
                o[2 * d] = __builtin_elementwise_fma(__builtin_amdgcn_cvt_pk_f32_fp8(wd, false), wk2, o[2 * d]);
                o[2 * d + 1] = __builtin_elementwise_fma(__builtin_amdgcn_cvt_pk_f32_fp8(wd, true), wk2, o[2 * d + 1]); } }
        f32x2 r4[4], r2[2], r1;
#pragma unroll
        for (int j = 0; j < 4; ++j) { const f32x2 snd = X.q2 ? o[j] : o[j + 4], kp = X.q2 ? o[j + 4] : o[j]; r4[j].x = kp.x + __shfl_xor(snd.x, 32); r4[j].y = kp.y + __shfl_xor(snd.y, 32); }
#pragma unroll
        for (int j = 0; j < 2; ++j) { const f32x2 snd = X.q1 ? r4[j] : r4[j + 2], kp = X.q1 ? r4[j + 2] : r4[j]; r2[j].x = kp.x + __shfl_xor(snd.x, 16); r2[j].y = kp.y + __shfl_xor(snd.y, 16); }
        { const f32x2 snd = X.q0 ? r2[0] : r2[1], kp = X.q0 ? r2[1] : r2[0]; r1.x = kp.x + __shfl_xor(snd.x, 8); r1.y = kp.y + __shfl_xor(snd.y, 8); }
        const f32x2 h2 = hv + r1;
        *(GAS f32x2*)((char*)X.H2 + eo * 4u) = h2;
        *(GAS unsigned*)((char*)X.H2b + eo * 2u) = pk2(h2.x, h2.y);
        const float ss = wave_sum(h2.x * h2.x + h2.y * h2.y);
        if (X.lane == 0) X.PART3[(size_t)t * 16 + s] = ss;
    }
}
template <int step> __device__ __forceinline__ void phase6ac(const Args& A, int lane, int wave) {
    unsigned char* ws = A.ws;
    P6Ctx X;
    X.TAB = ws + (step ? WS_V8 : WS_U8); X.IDX = (const int*)(ws + WS_IDX); X.W = (const float*)(ws + WS_GW); X.H = (const float*)(ws + WS_UBUF); X.RS2 = (const float*)(ws + WS_RS2); X.gf = A.in[8];
    X.PA = (float*)(ws + WS_PA); X.H2 = (float*)(ws + WS_PA); X.H2b = (bf16*)(ws + WS_XN); X.PART3 = (float*)(ws + WS_PART3);
    X.xg = blockIdx.x & 7; X.tbase = 256 * (blockIdx.x >> 3) + wave; X.q = lane >> 3; X.c = lane & 7; X.lane = lane;
    X.c2 = X.c & 4; X.c1 = X.c & 2; X.c0 = X.c & 1; X.q2 = X.q & 4; X.q1 = X.q & 2; X.q0 = X.q & 1;
    v4u ev[4], wA[16], wB[16];
    p6_load_ev(X, ev, 0);
    p6_load_rows<0>(X, wA, ev, 0); p6_load_rows<1>(X, wA, ev, 0);
    p6_load_ev(X, ev, 1);
#pragma unroll 1
    for (int it = 0; it < 64; it += 2) {
        p6_load_rows<0>(X, wB, ev, it + 1);
        p6_item<step>(X, wA, it, wB, ev, true);
        const bool more = it + 2 < 64;
        if (more) p6_load_rows<0>(X, wA, ev, it + 2);
        p6_item<step>(X, wB, it + 1, wA, ev, more);
    }
}
__device__ __forceinline__ void phase6b(const Args& A, int tid) {
    unsigned char* ws = A.ws;
    const float* PA = (const float*)(ws + WS_PA); float* GW = (float*)(ws + WS_GW);
    const size_t gtid = (size_t)blockIdx.x * NTHR + tid, nthr = (size_t)gridDim.x * NTHR;
    for (size_t i = gtid; i < (size_t)NT * 128 / 4; i += nthr) {
        f32x4 a = (f32x4){0.f, 0.f, 0.f, 0.f};
#pragma unroll
        for (int s = 0; s < 16; ++s) a += ((const GAS f32x4*)(PA + (size_t)s * ((size_t)NT * 128)))[i];
        const f32x4 gv = ((const GAS f32x4*)GW)[i];
        f32x4 o; o.x = gelu_erf(a.x) * gv.x; o.y = gelu_erf(a.y) * gv.y; o.z = gelu_erf(a.z) * gv.z; o.w = gelu_erf(a.w) * gv.w;
        ((GAS f32x4*)GW)[i] = o * (1.0f / 256.0f);
    }
}
__device__ __forceinline__ void phase8(const Args& A, int lane, int wave) {
    const float* PART2 = (const float*)(A.ws + WS_PART2); const float* gfin = A.in[16]; float* out = A.out;
    const int gw = blockIdx.x * NWAVES + wave, NGW = gridDim.x * NWAVES;
    for (int t = gw; t < NT; t += NGW) {
        float ps = PART2[(size_t)t * 32 + (lane & 31)];
        ps += __shfl_xor(ps, 1); ps += __shfl_xor(ps, 2); ps += __shfl_xor(ps, 4); ps += __shfl_xor(ps, 8); ps += __shfl_xor(ps, 16);
        const float rstd = 1.0f / sqrtf(ps * (1.0f / DM) + EPS);
        GAS f32x4* r = (GAS f32x4*)(out + (size_t)t * DM) + lane; const GAS f32x4* gr = (const GAS f32x4*)gfin + lane;
#pragma unroll
        for (int j = 0; j < 8; ++j) r[64 * j] = r[64 * j] * rstd * gr[64 * j];
    }
}

__global__ void __launch_bounds__(NTHR, 2) mk_fwd(Args args) {
    extern __shared__ __attribute__((aligned(16))) unsigned char lds_raw[];
    LAS unsigned char* lds = (LAS unsigned char*)lds_raw;
    int tid = threadIdx.x, lane = tid & 63, wave = __builtin_amdgcn_readfirstlane(tid >> 6);
#define FRESH_TID() do { tid = threadIdx.x; asm volatile("" : "+v"(tid)); lane = tid & 63; wave = __builtin_amdgcn_readfirstlane(tid >> 6); { const __attribute__((address_space(4))) Args* kp_ = (const __attribute__((address_space(4))) Args*)__builtin_amdgcn_kernarg_segment_ptr(); asm volatile("" : "+s"(kp_)); __builtin_memcpy(&pa, (const void*)kp_, sizeof(Args)); ws = pa.ws; } } while (0)
    volatile LAS unsigned* MISC = (volatile LAS unsigned*)(lds + MISC_OFF);
    if (tid < 32) MISC[tid] = 0u;
    __syncthreads();
    unsigned char* ws = args.ws; Args pa = args;
    XcdBarrier bar = xcd_barrier_post((unsigned*)(ws + WS_CTL) + CW_BAR, MISC + 8);
    const int G = gridDim.x, bx = blockIdx.x;

#ifndef NO_P0
    FRESH_TID(); phase0(pa, lds, tid, lane, wave);
#endif
    xcd_barrier(bar);
#if defined(STOP_AFTER) && STOP_AFTER == 1
    return;
#endif

#ifdef DUP_P0
    FRESH_TID(); phase0(pa, lds, tid, lane, wave);
    xcd_barrier(bar);
#if defined(STOP_AFTER) && STOP_AFTER == 2
    return;
#endif

#endif
#ifdef DUP_P1
#define NREP_P1 2
#else
#define NREP_P1 1
#endif
#pragma unroll 1
    for (int rep1 = 0; rep1 < NREP_P1; ++rep1) { FRESH_TID();
        pg8::Gemm g{(const bf16*)(ws + WS_XN), (const bf16*)(ws + WS_WIN), NT, PROJW, DM}; pg8::StaticOrder S; S.init(NT, PROJW, G, bx);
        pg8::EpiBf16<0> E{(bf16*)(ws + WS_PROJ), PROJW, nullptr, 0, 0, 1.f};
        pg8::gemm_phase<pg8::EpiBf16<0>, pg8::StaticOrder, true, true>(lds, g, S, E);
        pg8::Gemm g2{(const bf16*)(ws + WS_P16), (const bf16*)(ws + WS_WP), NT, DM, 256}; pg8::StaticOrder S2; S2.init(NT, DM, G, bx);
        pg8::EpiBf16<0> E2{(bf16*)(ws + WS_PP), DM, nullptr, 0, 0, 1.f};
        pg8::gemm_phase<pg8::EpiBf16<0>, pg8::StaticOrder, true, true>(lds, g2, S2, E2);
    }
    xcd_barrier(bar);
#if defined(STOP_AFTER) && STOP_AFTER == 3
    return;
#endif

#ifdef DUP_X
#define NREP_X 2
#else
#define NREP_X 1
#endif
#pragma unroll 1
    for (int rep = 0; rep < NREP_X; ++rep) {
#ifndef NO_X1
    FRESH_TID(); phase_x1(pa, lds, tid, lane, wave);
#endif
    xcd_barrier(bar);
#if defined(STOP_AFTER) && STOP_AFTER == 4
    return;
#endif

#ifndef NO_X2
    FRESH_TID(); phase_x2(pa, tid);
#endif
    xcd_barrier(bar);
#if defined(STOP_AFTER) && STOP_AFTER == 5
    return;
#endif

#ifndef NO_X3
    FRESH_TID(); phase_x3(pa, lds, tid, lane, wave);
#endif
    xcd_barrier(bar);
#if defined(STOP_AFTER) && STOP_AFTER == 6
    return;
#endif

    }
    { FRESH_TID();
        pg8::Gemm g{(const bf16*)(ws + WS_Y), (const bf16*)(ws + WS_WOUT), NT, DM, DM}; pg8::StaticOrder S; S.init(NT, DM, G, bx);
        pg8::EpiResidual E{args.in[0], (float*)(ws + WS_UBUF), (bf16*)(ws + WS_XN), (float*)(ws + WS_PART), DM};
        pg8::gemm_phase<pg8::EpiResidual, pg8::StaticOrder, true, true>(lds, g, S, E);
    }
    xcd_barrier(bar);
#if defined(STOP_AFTER) && STOP_AFTER == 7
    return;
#endif

    { FRESH_TID();
        pg8::Gemm g{(const bf16*)(ws + WS_XN), (const bf16*)(ws + WS_WQ), NT, DM, DM}; pg8::StaticOrder S; S.init(NT, DM, G, bx);
        LAS float* rs = (LAS float*)(lds + RS_OFF);
        pg8::Unit u0; FRESH_TID();
        if (S.next(0, u0)) {
            const float* PART = (const float*)(ws + WS_PART);
            const int row = tid >> 1, hf = tid & 1; const float* pr = PART + (size_t)(u0.pm * 256 + row) * 32 + hf * 16; float s = 0.f;
#pragma unroll
            for (int i = 0; i < 4; ++i) { const f32x4 v = *(const GAS f32x4*)(pr + 4 * i); s += (v.x + v.y) + (v.z + v.w); }
            s += __shfl_xor(s, 1);
            if (hf == 0) { const float r = 1.0f / sqrtf(s * (1.0f / DM) + EPS); rs[row] = r; if (u0.pn == 0) ((float*)(ws + WS_RS2))[u0.pm * 256 + row] = r; }
        }
        __syncthreads();
        pg8::EpiRowScaleBf16 E{(bf16*)(ws + WS_Y), DM, (const PG8_LAS float*)rs};
        pg8::gemm_phase<pg8::EpiRowScaleBf16, pg8::StaticOrder, true, true>(lds, g, S, E);
    }
    xcd_barrier(bar);
#if defined(STOP_AFTER) && STOP_AFTER == 8
    return;
#endif

#ifndef NO_P5
    FRESH_TID(); phase5(pa, lds, tid, lane, wave);
#endif
    xcd_barrier(bar);
#if defined(STOP_AFTER) && STOP_AFTER == 9
    return;
#endif

#ifdef DUP_P5
    FRESH_TID(); phase5(pa, lds, tid, lane, wave);
    xcd_barrier(bar);
#if defined(STOP_AFTER) && STOP_AFTER == 10
    return;
#endif

#endif
#ifdef DUP_6A
    FRESH_TID(); phase6ac<0>(pa, lane, wave);
    xcd_barrier(bar);
#endif
    FRESH_TID(); phase6ac<0>(pa, lane, wave);
    xcd_barrier(bar);
#if defined(STOP_AFTER) && STOP_AFTER == 11
    return;
#endif

    FRESH_TID(); phase6b(pa, tid);
    xcd_barrier(bar);
#if defined(STOP_AFTER) && STOP_AFTER == 12
    return;
#endif

#ifdef DUP_6C
    FRESH_TID(); phase6ac<1>(pa, lane, wave);
    xcd_barrier(bar);
#endif
    FRESH_TID(); phase6ac<1>(pa, lane, wave);
    xcd_barrier(bar);
#if defined(STOP_AFTER) && STOP_AFTER == 13
    return;
#endif

    { FRESH_TID();
        pg8::Gemm g{(const bf16*)(ws + WS_XN), (const bf16*)(ws + WS_WG), NT, DM, DM}; pg8::StaticOrder S; S.init(NT, DM, G, bx);
        LAS float* rs = (LAS float*)(lds + RS_OFF);
        pg8::Unit u0; FRESH_TID();
        if (S.next(0, u0)) {
            const float* PART3 = (const float*)(ws + WS_PART3);
            const int row = tid >> 1, hf = tid & 1; const float* pr = PART3 + (size_t)(u0.pm * 256 + row) * 16 + hf * 8; float s = 0.f;
#pragma unroll
            for (int i = 0; i < 2; ++i) { const f32x4 v = *(const GAS f32x4*)(pr + 4 * i); s += (v.x + v.y) + (v.z + v.w); }
            s += __shfl_xor(s, 1);
            if (hf == 0) rs[row] = 1.0f / sqrtf(s * (1.0f / DM) + EPS);
        }
        __syncthreads();
#ifdef DBG_H1
        pg8::EpiGate E{(const float*)(ws + WS_UBUF), (const bf16*)(ws + WS_PP), args.out,
#else
        pg8::EpiGate E{(const float*)(ws + WS_PA), (const bf16*)(ws + WS_PP), args.out,
#endif
            (float*)(ws + WS_PART2), DM, (const PG8_LAS float*)rs};
        pg8::gemm_phase<pg8::EpiGate, pg8::StaticOrder, true, true>(lds, g, S, E);
    }
    xcd_barrier(bar);
#if defined(STOP_AFTER) && STOP_AFTER == 14
    return;
#endif

#ifndef NO_P8
    FRESH_TID(); phase8(pa, lane, wave);
#endif
}

extern "C" void kernel_launch(void* const* d_in, const int* in_sizes, int n_in, void* d_out, int out_size, void* d_ws, size_t ws_size, hipStream_t stream) {
    static int grid = 0;
    if (grid == 0) {
        if (n_in != 17 || out_size != NT * DM || ws_size < WS_END) { fprintf(stderr, "kernel_launch: unexpected shapes (n_in %d, out %d, ws %zu); nothing launched\n", n_in, out_size, ws_size); grid = -1; return; }
        int dev = 0, cus = 0, per_cu = 0;
        if (hipGetDevice(&dev) != hipSuccess || hipDeviceGetAttribute(&cus, hipDeviceAttributeMultiprocessorCount, dev) != hipSuccess) { grid = -1; return; }
        if (hipFuncSetAttribute((const void*)mk_fwd, hipFuncAttributeMaxDynamicSharedMemorySize, LDS_BYTES) != hipSuccess) { fprintf(stderr, "kernel_launch: hipFuncSetAttribute failed\n"); grid = -1; return; }
        if (hipOccupancyMaxActiveBlocksPerMultiprocessor(&per_cu, (const void*)mk_fwd, NTHR, LDS_BYTES) != hipSuccess || per_cu < 1) { fprintf(stderr, "kernel_launch: occupancy query says %d blocks per CU\n", per_cu); }
        (void)hipGetLastError();
        grid = cus;
    }
    if (grid < 0) return;
    (void)hipMemsetAsync((char*)d_ws + WS_CTL, 0, CTL_ZERO_BYTES, stream);
    Args a{};
    for (int i = 0; i < 17; ++i) a.in[i] = (const float*)d_in[i];
    a.out = (float*)d_out; a.ws = (unsigned char*)d_ws; a.pad = 0ull;
    hipLaunchKernelGGL(mk_fwd, dim3(grid), dim3(NTHR), LDS_BYTES, stream, a);
}
```
